# Optimizing an MI355X kernel written in HIP

```python
import math
import jax, jax.numpy as jnp
from jax import lax
import numpy as np

D_MODEL = 1024
BATCH = 16
SEQ = 2048
DEPTH = 4

HEAD_DIM = 64
N_HEADS = D_MODEL // HEAD_DIM
D_FF = 2816
NORM_EPS = 1e-6
N_MIXERS = 3

REL_BUCKETS = 32
REL_MAX_DIST = 1024

QBLK = 128

A_KV_HEADS = 2
A_WINDOW = 128

B_KV_GROUPS = 4
CMP_LEN = 32
CMP_STRIDE = 16
CMP_HIDDEN = 256
SLC_BLK = 64
SLC_TOPK = 16
B_WINDOW = 512
B_QCHUNK = 128

MOBA_BLK = 256
MOBA_TOPK = 3
MOBA_QCHUNK = 64

NEG = -1e30
TINY = 1e-30

A_IN = N_HEADS * HEAD_DIM + 2 * A_KV_HEADS * HEAD_DIM
B_IN = N_HEADS * HEAD_DIM + 6 * B_KV_GROUPS * HEAD_DIM + 3 * N_HEADS
C_IN = 3 * N_HEADS * HEAD_DIM

N_A_LAYERS = (DEPTH + 2) // 3
N_B_LAYERS = (DEPTH + 1) // 3
N_C_LAYERS = DEPTH // 3

kernel_name = "hybrid_swa_nsa_moba_macaron"


def rms_norm(x, g):
    xf = x.astype(jnp.float32)
    y = xf * lax.rsqrt(jnp.mean(xf * xf, axis=-1, keepdims=True) + NORM_EPS)
    return (y * g.astype(jnp.float32)).astype(x.dtype)


def swiglu(h, w_in, w_out):
    gate, up = jnp.split(h @ w_in, 2, axis=-1)
    return (jax.nn.silu(gate) * up) @ w_out


def rel_bucket(dist):
    dist = jnp.maximum(dist, 0)
    exact = REL_BUCKETS // 2
    d = jnp.maximum(dist, 1).astype(jnp.float32)
    log_b = exact + (jnp.log(d / exact) / math.log(REL_MAX_DIST / exact)
                     * (REL_BUCKETS - exact)).astype(jnp.int32)
    return jnp.where(dist < exact, dist, jnp.minimum(log_b, REL_BUCKETS - 1))


def masked_softmax(s, ok, sink=None):
    s = jnp.where(ok, s, NEG)
    m = jnp.max(s, axis=-1, keepdims=True)
    if sink is not None:
        m = jnp.maximum(m, sink)
    e = jnp.where(ok, jnp.exp(s - m), 0.0)
    denom = jnp.sum(e, axis=-1, keepdims=True)
    if sink is not None:
        denom = denom + jnp.exp(sink - m)
    return e / jnp.maximum(denom, TINY)


def banded_attention(q, k, v, rel_table, window, sinks=None):
    B, S, H, dh = q.shape
    G = k.shape[2]
    R = H // G
    n_prev = -(-(window - 1) // QBLK)
    pad = n_prev * QBLK
    slab = pad + QBLK
    kp = jnp.pad(k, ((0, 0), (pad, 0), (0, 0), (0, 0)))
    vp = jnp.pad(v, ((0, 0), (pad, 0), (0, 0), (0, 0)))
    n_blk = S // QBLK
    qb = q.reshape(B, n_blk, QBLK, G, R, dh).transpose(1, 0, 2, 3, 4, 5)
    qi = jnp.arange(QBLK)[:, None]
    kj = jnp.arange(slab)[None, :]
    dist = pad + qi - kj
    in_band = (dist >= 0) & (dist < window)
    bias = rel_table.astype(jnp.float32)[rel_bucket(dist)]
    bias = bias.reshape(QBLK, slab, G, R).transpose(2, 3, 0, 1)
    sink = None if sinks is None else sinks.astype(jnp.float32).reshape(G, R, 1, 1)
    scale = dh ** -0.5

    def block(args):
        n, q_n = args
        start = n * QBLK
        k_n = lax.dynamic_slice_in_dim(kp, start, slab, axis=1)
        v_n = lax.dynamic_slice_in_dim(vp, start, slab, axis=1)
        s = jnp.einsum("bqgrd,bkgd->bgrqk", q_n, k_n).astype(jnp.float32) * scale + bias
        ok = in_band & (start - pad + kj >= 0)
        p = masked_softmax(s, ok, sink)
        o = jnp.einsum("bgrqk,bkgd->bqgrd", p.astype(v.dtype), v_n)
        return o.reshape(B, QBLK, H, dh)

    out = lax.map(block, (jnp.arange(n_blk), qb))
    return out.transpose(1, 0, 2, 3, 4).reshape(B, S, H, dh)


def sliding_sink_attention(h, w_in, w_out, sinks, rel_table):
    B, S, _ = h.shape
    qw, kw = N_HEADS * HEAD_DIM, A_KV_HEADS * HEAD_DIM
    q, k, v = jnp.split(h @ w_in, [qw, qw + kw], axis=-1)
    q = q.reshape(B, S, N_HEADS, HEAD_DIM)
    k = k.reshape(B, S, A_KV_HEADS, HEAD_DIM)
    v = v.reshape(B, S, A_KV_HEADS, HEAD_DIM)
    o = banded_attention(q, k, v, rel_table, A_WINDOW, sinks)
    return o.reshape(B, S, -1) @ w_out


def compress_kv(kv, pos, w1, w2):
    B, S, G, dh = kv.shape
    n_cmp = (S - CMP_LEN) // CMP_STRIDE + 1
    idx = jnp.arange(n_cmp)[:, None] * CMP_STRIDE + jnp.arange(CMP_LEN)[None, :]
    blocks = kv[:, idx] + pos[:, None, :]
    flat = blocks.transpose(0, 1, 3, 2, 4).reshape(B, n_cmp, G, CMP_LEN * dh)
    return jax.nn.gelu(flat @ w1) @ w2


def selected_block_attention(q, k, v, sel_idx, rel_table):
    B, S, G, R, dh = q.shape
    n_sel = sel_idx.shape[-1]
    n_slc = S // SLC_BLK
    kb = k.reshape(B, n_slc, SLC_BLK, G, dh).transpose(0, 3, 1, 2, 4)
    vb = v.reshape(B, n_slc, SLC_BLK, G, dh).transpose(0, 3, 1, 2, 4)
    table_g = rel_table.astype(jnp.float32).reshape(REL_BUCKETS, G, R).transpose(1, 0, 2)
    g_ix = jnp.arange(G)[:, None, None]
    n_q = S // B_QCHUNK
    n_keys = n_sel * SLC_BLK
    scale = dh ** -0.5

    def chunk(i):
        b, c = i // n_q, i % n_q
        start = c * B_QCHUNK
        q_c = lax.dynamic_slice_in_dim(q[b], start, B_QCHUNK, axis=0)
        idx = lax.dynamic_slice_in_dim(sel_idx[b], start, B_QCHUNK, axis=1)
        k_sel = kb[b][g_ix, idx].reshape(G, B_QCHUNK, n_keys, dh)
        v_sel = vb[b][g_ix, idx].reshape(G, B_QCHUNK, n_keys, dh)
        pos = (idx[..., None] * SLC_BLK + jnp.arange(SLC_BLK)).reshape(G, B_QCHUNK, n_keys)
        t = start + jnp.arange(B_QCHUNK)
        dist = t[None, :, None] - pos
        bias = table_g[g_ix, rel_bucket(dist)].transpose(0, 3, 1, 2)
        s = jnp.einsum("qgrd,gqkd->grqk", q_c, k_sel).astype(jnp.float32) * scale + bias
        p = masked_softmax(s, (dist >= 0)[:, None])
        o = jnp.einsum("grqk,gqkd->qgrd", p.astype(v.dtype), v_sel)
        return o.reshape(B_QCHUNK, G * R, dh)

    out = lax.map(chunk, jnp.arange(B * n_q))
    return out.reshape(B, S, G * R, dh)


def nsa_attention(h, w_in, w_out, cmp_pos, cmp_w1, cmp_w2, rel_table):
    B, S, _ = h.shape
    G, R, dh = B_KV_GROUPS, N_HEADS // B_KV_GROUPS, HEAD_DIM
    kvw = G * dh
    splits = np.cumsum([N_HEADS * dh] + [kvw] * 6).tolist()
    q, kc, vc, ks, vs, kw, vw, gate = jnp.split(h @ w_in, splits, axis=-1)
    q = q.reshape(B, S, G, R, dh)
    to_kv = lambda a: a.reshape(B, S, G, dh)
    scale = dh ** -0.5
    t = jnp.arange(S)

    kc_b = compress_kv(to_kv(kc), cmp_pos[0], cmp_w1[0], cmp_w2[0])
    vc_b = compress_kv(to_kv(vc), cmp_pos[1], cmp_w1[1], cmp_w2[1])
    n_cmp = kc_b.shape[1]
    cmp_end = jnp.arange(n_cmp) * CMP_STRIDE + CMP_LEN - 1
    s_cmp = jnp.einsum("bsgrd,bngd->bgrsn", q, kc_b).astype(jnp.float32) * scale
    p_cmp = masked_softmax(s_cmp, cmp_end[None, :] <= t[:, None])
    o_cmp = jnp.einsum("bgrsn,bngd->bsgrd", p_cmp.astype(vc_b.dtype), vc_b)

    n_slc = S // SLC_BLK
    n_sel = min(SLC_TOPK, n_slc)
    c_start = np.arange(n_cmp)[:, None] * CMP_STRIDE
    s_start = np.arange(n_slc)[None, :] * SLC_BLK
    overlap = ((c_start < s_start + SLC_BLK) & (c_start + CMP_LEN > s_start)).astype(np.float32)
    imp = jnp.einsum("bgrsn,nj->bgsj", p_cmp, jnp.asarray(overlap))
    cur = (t // SLC_BLK)[:, None]
    j = jnp.arange(n_slc)[None, :]
    forced = (j == 0) | (j == cur) | (j == cur - 1)
    imp = jnp.where(j > cur, NEG, jnp.where(forced, -NEG, imp))
    _, sel_idx = lax.top_k(imp, n_sel)
    o_slc = selected_block_attention(q, to_kv(ks), to_kv(vs), sel_idx, rel_table)

    o_win = banded_attention(q.reshape(B, S, N_HEADS, dh), to_kv(kw), to_kv(vw),
                             rel_table, B_WINDOW)

    g = jax.nn.sigmoid(gate.astype(jnp.float32)).reshape(B, S, N_HEADS, 3).astype(o_win.dtype)
    o = (g[..., 0:1] * o_cmp.reshape(B, S, N_HEADS, dh)
         + g[..., 1:2] * o_slc + g[..., 2:3] * o_win)
    return o.reshape(B, S, -1) @ w_out


def moba_attention(h, w_in, w_out, rel_table):
    B, S, _ = h.shape
    H, dh = N_HEADS, HEAD_DIM
    q, k, v = jnp.split(h @ w_in, 3, axis=-1)
    q = q.reshape(B, S, H, dh)
    k = k.reshape(B, S, H, dh)
    v = v.reshape(B, S, H, dh)
    n_blk = -(-S // MOBA_BLK)
    s_pad = n_blk * MOBA_BLK
    kb = jnp.pad(k, ((0, 0), (0, s_pad - S), (0, 0), (0, 0))).reshape(B, n_blk, MOBA_BLK, H, dh)
    vb = jnp.pad(v, ((0, 0), (0, s_pad - S), (0, 0), (0, 0))).reshape(B, n_blk, MOBA_BLK, H, dh)
    n_top = min(MOBA_TOPK, n_blk - 1)
    table = rel_table.astype(jnp.float32)
    table_h = table.T
    scale = dh ** -0.5
    t = jnp.arange(S)
    if n_top > 0:
        k_mean = jnp.mean(kb.astype(jnp.float32), axis=2).astype(q.dtype)
        gate = jnp.einsum("bshd,bnhd->bhsn", q, k_mean).astype(jnp.float32)
        past = jnp.arange(n_blk)[None, :] < (t // MOBA_BLK)[:, None]
        _, sel = lax.top_k(jnp.where(past, gate, NEG), n_top)
        kbh = kb.transpose(0, 3, 1, 2, 4)
        vbh = vb.transpose(0, 3, 1, 2, 4)
    h_ix = jnp.arange(H)[:, None, None]
    n_q = S // MOBA_QCHUNK

    def chunk(i):
        b, c = i // n_q, i % n_q
        start = c * MOBA_QCHUNK
        q_c = lax.dynamic_slice_in_dim(q[b], start, MOBA_QCHUNK, axis=0)
        tq = start + jnp.arange(MOBA_QCHUNK)
        own = start // MOBA_BLK
        k_own = lax.dynamic_index_in_dim(kb[b], own, axis=0, keepdims=False)
        v_own = lax.dynamic_index_in_dim(vb[b], own, axis=0, keepdims=False)
        d_own = tq[:, None] - (own * MOBA_BLK + jnp.arange(MOBA_BLK))[None, :]
        s_own = (jnp.einsum("qhd,khd->hqk", q_c, k_own).astype(jnp.float32) * scale
                 + table[rel_bucket(d_own)].transpose(2, 0, 1))
        ok_own = jnp.broadcast_to(d_own >= 0, s_own.shape)
        if n_top == 0:
            p = masked_softmax(s_own, ok_own)
            return jnp.einsum("hqk,khd->qhd", p.astype(v.dtype), v_own)
        idx = lax.dynamic_slice_in_dim(sel[b], start, MOBA_QCHUNK, axis=1)
        n_keys = n_top * MOBA_BLK
        k_sel = kbh[b][h_ix, idx].reshape(H, MOBA_QCHUNK, n_keys, dh)
        v_sel = vbh[b][h_ix, idx].reshape(H, MOBA_QCHUNK, n_keys, dh)
        pos = (idx[..., None] * MOBA_BLK + jnp.arange(MOBA_BLK)).reshape(H, MOBA_QCHUNK, n_keys)
        d_sel = tq[None, :, None] - pos
        s_sel = (jnp.einsum("qhd,hqkd->hqk", q_c, k_sel).astype(jnp.float32) * scale
                 + table_h[h_ix, rel_bucket(d_sel)])
        ok_sel = jnp.broadcast_to((idx < own)[..., None],
                                  (H, MOBA_QCHUNK, n_top, MOBA_BLK)).reshape(H, MOBA_QCHUNK, n_keys)
        p = masked_softmax(jnp.concatenate([s_own, s_sel], axis=-1),
                           jnp.concatenate([ok_own, ok_sel], axis=-1)).astype(v.dtype)
        return (jnp.einsum("hqk,khd->qhd", p[..., :MOBA_BLK], v_own)
                + jnp.einsum("hqk,hqkd->qhd", p[..., MOBA_BLK:], v_sel))

    out = lax.map(chunk, jnp.arange(B * n_q))
    return out.reshape(B, S, H * dh) @ w_out


def setup_inputs(seed: int = 0) -> dict:
    key = jax.random.key(seed)
    ks = jax.random.split(key, 16)
    f32 = jnp.float32
    hd = N_HEADS * HEAD_DIM

    def nrm(k, shape, fan_in):
        return jax.random.normal(k, shape, f32) * fan_in ** -0.5

    return {
        "x": jax.random.normal(ks[0], (BATCH, SEQ, D_MODEL), f32),
        "rel_bias": 0.5 * jax.random.normal(ks[1], (REL_BUCKETS, N_HEADS), f32),
        "norm_g": 1.0 + 0.05 * jax.random.normal(ks[2], (DEPTH, 6, D_MODEL), f32),
        "ffn_w_in": nrm(ks[3], (DEPTH, 2, D_MODEL, 2 * D_FF), D_MODEL),
        "ffn_w_out": nrm(ks[4], (DEPTH, 2, D_FF, D_MODEL), D_FF),
        "a_w_in": nrm(ks[5], (N_A_LAYERS, D_MODEL, A_IN), D_MODEL),
        "a_w_out": nrm(ks[6], (N_A_LAYERS, hd, D_MODEL), hd),
        "a_sinks": jax.random.normal(ks[7], (N_A_LAYERS, N_HEADS), f32),
        "b_w_in": nrm(ks[8], (N_B_LAYERS, D_MODEL, B_IN), D_MODEL),
        "b_w_out": nrm(ks[9], (N_B_LAYERS, hd, D_MODEL), hd),
        "b_cmp_pos": 0.5 * jax.random.normal(ks[10], (N_B_LAYERS, 2, CMP_LEN, HEAD_DIM), f32),
        "b_cmp_w1": nrm(ks[11], (N_B_LAYERS, 2, CMP_LEN * HEAD_DIM, CMP_HIDDEN), CMP_LEN * HEAD_DIM),
        "b_cmp_w2": nrm(ks[12], (N_B_LAYERS, 2, CMP_HIDDEN, HEAD_DIM), CMP_HIDDEN),
        "c_w_in": nrm(ks[13], (N_C_LAYERS, D_MODEL, C_IN), D_MODEL),
        "c_w_out": nrm(ks[14], (N_C_LAYERS, hd, D_MODEL), hd),
    }


def reference(x, rel_bias, norm_g, ffn_w_in, ffn_w_out, a_w_in, a_w_out, a_sinks,
              b_w_in, b_w_out, b_cmp_pos, b_cmp_w1, b_cmp_w2, c_w_in, c_w_out):
    for i in range(DEPTH):
        g = norm_g[i]
        x = x + 0.5 * rms_norm(swiglu(rms_norm(x, g[0]), ffn_w_in[i, 0], ffn_w_out[i, 0]), g[1])
        hm = rms_norm(x, g[2])
        kind, j = i % N_MIXERS, i // N_MIXERS
        if kind == 0:
            m = sliding_sink_attention(hm, a_w_in[j], a_w_out[j], a_sinks[j], rel_bias)
        elif kind == 1:
            m = nsa_attention(hm, b_w_in[j], b_w_out[j], b_cmp_pos[j], b_cmp_w1[j],
                              b_cmp_w2[j], rel_bias)
        else:
            m = moba_attention(hm, c_w_in[j], c_w_out[j], rel_bias)
        x = x + rms_norm(m, g[3])
        x = x + 0.5 * rms_norm(swiglu(rms_norm(x, g[4]), ffn_w_in[i, 1], ffn_w_out[i, 1]), g[5])
    return x
```

```cpp
#define FAST_A 1
#define FAST_C 1
#define FAST_B 1
#define FAST_CMP 1
#include <hip/hip_runtime.h>
#include <cstdio>
#include <cstdint>
namespace pg8 {
#define PG8_LAS __attribute__((address_space(3)))
typedef unsigned short bf16_t;
typedef short bf16x8 __attribute__((ext_vector_type(8)));
typedef float f32x4 __attribute__((ext_vector_type(4)));
typedef unsigned u32x4 __attribute__((ext_vector_type(4)));
constexpr int BM = 256, BK = 64, HALF = 128, HTB = HALF * BK * 2  , STAGE_BYTES = 8 * HTB, NXCD = 8, WGM = 8;

__host__ __device__ __forceinline__ int lds_byte(int r, int c) { const int st = (r >> 4) * 2 + (c >> 5), rr = r & 15, cc = c & 31, ob = rr * 64 + cc * 2; return st * 1024 + (ob ^ (((ob >> 9) & 1) << 5)); }
__host__ __device__ __forceinline__ void stage_rc(int b, int& R, int& C) { const int st = b / 1024, sb = b % 1024, swz = sb ^ (((sb >> 9) & 1) << 5); R = (st >> 1) * 16 + swz / 64; C = (st & 1) * 32 + (swz % 64) / 2; }
__host__ __device__ __forceinline__ int perm32(int rho) { const int n = rho >> 4, i = rho & 15; return 8 * (i >> 2) + 4 * n + (i & 3); }

struct Unit { int pm, pn; };
struct Gemm { const bf16_t* A; const bf16_t* Bt; int M, N, K; };

struct StaticOrder {
    int nM, nN, nwg, G, c;
    __host__ __device__ void init(int M, int N, int G_, int c_) { nM = M / BM; nN = N / BM; nwg = nM * nN; G = G_; c = c_; }
    __host__ __device__ bool next(int i, Unit& u) const {
        const long L = (long)i * G + c; if (L >= nwg) return false;
        int wgid = (int)L; { const int q = nwg / NXCD, r = nwg % NXCD, xcd = wgid % NXCD, off = wgid / NXCD; wgid = (xcd < r ? xcd * (q + 1) : r * (q + 1) + (xcd - r) * q) + off; }
        const int nig = WGM * nN, gid = wgid / nig, fm = gid * WGM, gsz = (nM - fm) < WGM ? (nM - fm) : WGM;
        u.pm = fm + ((wgid % nig) % gsz); u.pn = (wgid % nig) / gsz; return true;
    }
    __device__ __forceinline__ void a_ready(const Unit&) const {}
    __device__ __forceinline__ void done(const Unit&) const {}
};

__device__ __forceinline__ unsigned cvt_pk_bf16(float lo, float hi) { unsigned r; asm volatile("v_cvt_pk_bf16_f32 %0, %1, %2" : "=v"(r) : "v"(lo), "v"(hi)); return r; }
struct EpiStore {
    static constexpr bool PERM = true, AFTER_DRAIN = false;
    bf16_t* O; int ldc;
    __device__ __forceinline__ void operator()(const f32x4 (&acc)[2][2][4][2], const Unit& u, int wr, int wc, int fr, int fq) const {
        const int row0 = u.pm * BM + wr * 64 + fr; const int col0 = u.pn * BM + wc * 32 + 8 * fq;
#pragma unroll
        for (int ai = 0; ai < 2; ++ai)
#pragma unroll
            for (int m = 0; m < 4; ++m) { bf16_t* rowp = O + (size_t)(row0 + ai * HALF + m * 16) * ldc + col0;
#pragma unroll
                for (int bj = 0; bj < 2; ++bj) { const f32x4 v0 = acc[ai][bj][m][0], v1 = acc[ai][bj][m][1];
                    u32x4 w; w.x = cvt_pk_bf16(v0[0], v0[1]); w.y = cvt_pk_bf16(v0[2], v0[3]); w.z = cvt_pk_bf16(v1[0], v1[1]); w.w = cvt_pk_bf16(v1[2], v1[3]);
                    *(u32x4*)(rowp + bj * HALF) = w; } }
    }
};
__device__ __forceinline__ float silu_mul(float g, float u) { return g * __builtin_amdgcn_rcpf(1.0f + __builtin_amdgcn_exp2f(-1.4426950408889634f * g)) * u; }
struct EpiSwiglu {
    static constexpr bool PERM = true, AFTER_DRAIN = false;
    bf16_t* O; int ldc;
    __device__ __forceinline__ void operator()(const f32x4 (&acc)[2][2][4][2], const Unit& u, int wr, int wc, int fr, int fq) const {
        const int row0 = u.pm * BM + wr * 64 + fr; const int col0 = u.pn * HALF + wc * 32 + 8 * fq;
#pragma unroll
        for (int ai = 0; ai < 2; ++ai)
#pragma unroll
            for (int m = 0; m < 4; ++m) { bf16_t* rowp = O + (size_t)(row0 + ai * HALF + m * 16) * ldc + col0;
                const f32x4 g0 = acc[ai][0][m][0], g1 = acc[ai][0][m][1], u0 = acc[ai][1][m][0], u1 = acc[ai][1][m][1];
                u32x4 w; w.x = cvt_pk_bf16(silu_mul(g0[0], u0[0]), silu_mul(g0[1], u0[1])); w.y = cvt_pk_bf16(silu_mul(g0[2], u0[2]), silu_mul(g0[3], u0[3]));
                w.z = cvt_pk_bf16(silu_mul(g1[0], u1[0]), silu_mul(g1[1], u1[1])); w.w = cvt_pk_bf16(silu_mul(g1[2], u1[2]), silu_mul(g1[3], u1[3]));
                *(u32x4*)rowp = w; }
    }
};
template <class Epi, class Sched, bool ALIGN_EPI = false, bool SP2 = false>
__device__ __forceinline__ void gemm_phase(PG8_LAS unsigned char* lds, const Gemm g, const Sched& S, const Epi& E) {
    int tid_ = threadIdx.x; asm volatile("" : "+v"(tid_));
    const int tid = tid_, wid = __builtin_amdgcn_readfirstlane(tid >> 6), lane = tid & 63, wr = wid >> 2, wc = wid & 3, fr = lane & 15, fq = lane >> 4;
    const int K = g.K, nt = K / BK;
    unsigned voffA[2], voffB[2];
#pragma unroll
    for (int i = 0; i < 2; ++i) { int R, C; stage_rc(tid * 16 + i * 8192, R, C); const int Rb = Epi::PERM ? ((R & ~31) + perm32(R & 31)) : R;
        voffA[i] = (unsigned)(R * K + C) * 2u; voffB[i] = (unsigned)(Rb * K + C) * 2u; }
    const size_t kstep = (size_t)(BK * 2);
    const size_t hstep = (size_t)HALF * K * 2;
    const size_t tstep = 2 * hstep;
    const unsigned ldsw = (unsigned)wid * 1024u;
    const int aoff = lds_byte(wr * 64 + fr, fq * 8), boff = lds_byte(wc * 32 + fr, fq * 8);
#define PG8_SA(b, h) (((b) * 2 + (h)) * HTB)
#define PG8_SB(b, h) ((4 + (b) * 2 + (h)) * HTB)
#define PG8_STAGE(bufoff, gbase, voff) do { _Pragma("unroll") for (int _i = 0; _i < 2; ++_i) \
        __builtin_amdgcn_global_load_lds((const unsigned*)((const char*)(gbase) + (voff)[_i]), (PG8_LAS unsigned*)(lds + (bufoff) + ldsw + _i * 8192), 16, 0, 0); } while (0)
#define PG8_LDA(dst, b, h) do { _Pragma("unroll") for (int m = 0; m < 4; ++m) _Pragma("unroll") for (int k = 0; k < 2; ++k) dst[m][k] = *(const PG8_LAS bf16x8*)(lds + PG8_SA(b, h) + aoff + m * 2048 + k * 1024); } while (0)
#define PG8_LDB(dst, b, h) do { _Pragma("unroll") for (int n = 0; n < 2; ++n) _Pragma("unroll") for (int k = 0; k < 2; ++k) dst[n][k] = *(const PG8_LAS bf16x8*)(lds + PG8_SB(b, h) + boff + n * 2048 + k * 1024); } while (0)
#define PG8_MMA(ai, bj, At, Bt) do { __builtin_amdgcn_s_setprio(1); _Pragma("unroll") for (int m = 0; m < 4; ++m) _Pragma("unroll") for (int n = 0; n < 2; ++n) _Pragma("unroll") for (int k = 0; k < 2; ++k) \
        acc[ai][bj][m][n] = __builtin_amdgcn_mfma_f32_16x16x32_bf16(Bt[n][k], At[m][k], acc[ai][bj][m][n], 0, 0, 0); __builtin_amdgcn_s_setprio(0); } while (0)
#define PG8_WAIT_V(n) asm volatile("s_waitcnt vmcnt(" #n ")" ::: "memory")
#define PG8_WAIT_L(n) asm volatile("s_waitcnt lgkmcnt(" #n ")" ::: "memory")
#define PG8_BAR __builtin_amdgcn_s_barrier()
#define PG8_SCHED __builtin_amdgcn_sched_barrier(0)
    Unit cur, nxt; int ui = 0;
    if (!S.next(0, cur)) return;
    f32x4 acc[2][2][4][2];
#pragma unroll
    for (int a = 0; a < 2; ++a)
#pragma unroll
        for (int b = 0; b < 2; ++b)
#pragma unroll
            for (int m = 0; m < 4; ++m)
#pragma unroll
                for (int n = 0; n < 2; ++n) acc[a][b][m][n] = (f32x4){0.f, 0.f, 0.f, 0.f};
    bf16x8 At[4][2], B0[2][2], B1[2][2];
    const char* cA = (const char*)g.A + (size_t)cur.pm * tstep; const char* cB = (const char*)g.Bt + (size_t)cur.pn * tstep;
    S.a_ready(cur);
    if constexpr (SP2) {
        PG8_STAGE(PG8_SB(0, 0), cB, voffB); PG8_STAGE(PG8_SB(0, 1), cB + hstep, voffB); PG8_STAGE(PG8_SA(0, 0), cA, voffA); PG8_STAGE(PG8_SA(0, 1), cA + hstep, voffA);
        if (wr == 1) PG8_BAR;
        PG8_WAIT_V(2); PG8_BAR;
        PG8_STAGE(PG8_SB(1, 0), cB + kstep, voffB); PG8_STAGE(PG8_SA(1, 0), cA + kstep, voffA); PG8_STAGE(PG8_SB(1, 1), cB + hstep + kstep, voffB);
        PG8_WAIT_V(6); PG8_BAR;
    } else {
        PG8_STAGE(PG8_SB(0, 0), cB, voffB); PG8_STAGE(PG8_SA(0, 0), cA, voffA); PG8_STAGE(PG8_SB(0, 1), cB + hstep, voffB); PG8_STAGE(PG8_SA(0, 1), cA + hstep, voffA);
        if (wr == 1) PG8_BAR;
        PG8_WAIT_V(4); PG8_BAR;
        PG8_STAGE(PG8_SB(1, 0), cB + kstep, voffB); PG8_STAGE(PG8_SA(1, 0), cA + kstep, voffA); PG8_STAGE(PG8_SB(1, 1), cB + hstep + kstep, voffB);
        PG8_WAIT_V(6); PG8_BAR;
    }
    for (;;) {
        const bool has_next = S.next(ui + 1, nxt);
        const char* nA = has_next ? (const char*)g.A + (size_t)nxt.pm * tstep : cA; const char* nB = has_next ? (const char*)g.Bt + (size_t)nxt.pn * tstep : cB;
        for (int t = 0; t < nt; t += 2) {
            const bool last = (t == nt - 2);
            const char* a1 = cA + (size_t)(t + 1) * kstep;
            const char* a2 = last ? nA : cA + (size_t)(t + 2) * kstep; const char* b2 = last ? nB : cB + (size_t)(t + 2) * kstep;
            const char* a3 = a2 + kstep; const char* b3 = b2 + kstep;
            if (last && has_next) S.a_ready(nxt);
            if constexpr (SP2) {
            PG8_LDB(B0, 0, 0); PG8_LDB(B1, 0, 1); PG8_SCHED; PG8_LDA(At, 0, 0); PG8_STAGE(PG8_SA(1, 1), a1 + hstep, voffA);
            PG8_WAIT_V(8); PG8_WAIT_L(0); PG8_BAR; PG8_MMA(0, 0, At, B0); PG8_MMA(0, 1, At, B1); PG8_BAR; PG8_SCHED;
            PG8_LDA(At, 0, 1); PG8_STAGE(PG8_SB(0, 0), b2, voffB); PG8_STAGE(PG8_SB(0, 1), b2 + hstep, voffB); PG8_STAGE(PG8_SA(0, 0), a2, voffA);
            PG8_WAIT_V(8); PG8_WAIT_L(0); PG8_BAR; PG8_MMA(1, 0, At, B0); PG8_MMA(1, 1, At, B1); PG8_BAR; PG8_SCHED;
            PG8_LDB(B0, 1, 0); PG8_LDB(B1, 1, 1); PG8_SCHED; PG8_LDA(At, 1, 0); PG8_STAGE(PG8_SA(0, 1), a2 + hstep, voffA);
            PG8_WAIT_V(8); PG8_WAIT_L(0); PG8_BAR; PG8_MMA(0, 0, At, B0); PG8_MMA(0, 1, At, B1); PG8_BAR; PG8_SCHED;
            PG8_LDA(At, 1, 1); PG8_STAGE(PG8_SB(1, 0), b3, voffB); PG8_STAGE(PG8_SB(1, 1), b3 + hstep, voffB); PG8_STAGE(PG8_SA(1, 0), a3, voffA);
            PG8_WAIT_V(8); PG8_WAIT_L(0); PG8_BAR; PG8_MMA(1, 0, At, B0); PG8_MMA(1, 1, At, B1); PG8_BAR; PG8_SCHED;
            } else {
            PG8_LDB(B0, 0, 0); PG8_SCHED; PG8_LDA(At, 0, 0); PG8_STAGE(PG8_SA(1, 1), a1 + hstep, voffA);
            PG8_WAIT_L(8); PG8_BAR; PG8_WAIT_L(0); PG8_MMA(0, 0, At, B0); PG8_BAR; PG8_SCHED;
            PG8_LDB(B1, 0, 1); PG8_STAGE(PG8_SB(0, 0), b2, voffB);
            PG8_BAR; PG8_WAIT_L(0); PG8_MMA(0, 1, At, B1); PG8_BAR;
            PG8_LDA(At, 0, 1); PG8_STAGE(PG8_SA(0, 0), a2, voffA);
            PG8_BAR; PG8_WAIT_L(0); PG8_MMA(1, 0, At, B0); PG8_BAR; PG8_SCHED;
            PG8_STAGE(PG8_SB(0, 1), b2 + hstep, voffB);
            PG8_WAIT_V(6); PG8_BAR; PG8_MMA(1, 1, At, B1); PG8_BAR;
            PG8_LDB(B0, 1, 0); PG8_SCHED; PG8_LDA(At, 1, 0); PG8_STAGE(PG8_SA(0, 1), a2 + hstep, voffA);
            PG8_WAIT_L(8); PG8_BAR; PG8_WAIT_L(0); PG8_MMA(0, 0, At, B0); PG8_BAR; PG8_SCHED;
            PG8_LDB(B1, 1, 1); PG8_STAGE(PG8_SB(1, 0), b3, voffB);
            PG8_BAR; PG8_WAIT_L(0); PG8_MMA(0, 1, At, B1); PG8_BAR;
            PG8_LDA(At, 1, 1); PG8_STAGE(PG8_SA(1, 0), a3, voffA);
            PG8_BAR; PG8_WAIT_L(0); PG8_MMA(1, 0, At, B0); PG8_BAR; PG8_SCHED;
            PG8_STAGE(PG8_SB(1, 1), b3 + hstep, voffB);
            PG8_WAIT_V(6); PG8_BAR; PG8_MMA(1, 1, At, B1); PG8_BAR;
            }
        }
        if constexpr (ALIGN_EPI) { if (wr == 0) PG8_BAR; }
        if constexpr (!Epi::AFTER_DRAIN) { E(acc, cur, wr, wc, fr, fq); S.done(cur); }
        if (!has_next) break;
#pragma unroll
        for (int a = 0; a < 2; ++a)
#pragma unroll
            for (int b = 0; b < 2; ++b)
#pragma unroll
                for (int m = 0; m < 4; ++m)
#pragma unroll
                    for (int n = 0; n < 2; ++n) acc[a][b][m][n] = (f32x4){0.f, 0.f, 0.f, 0.f};
        cur = nxt; cA = nA; cB = nB; ++ui;
        if constexpr (ALIGN_EPI) { if (wr == 1) PG8_BAR; }
    }
    PG8_WAIT_V(0);
    if constexpr (!ALIGN_EPI) { if (wr == 0) PG8_BAR; }
    PG8_BAR;
    if constexpr (Epi::AFTER_DRAIN) { E.fused(acc, cur, wr, wc, fr, fq, lds, wid, lane); S.done(cur); }
#undef PG8_SA
#undef PG8_SB
#undef PG8_STAGE
#undef PG8_LDA
#undef PG8_LDB
#undef PG8_MMA
#undef PG8_WAIT_V
#undef PG8_WAIT_L
#undef PG8_BAR
#undef PG8_SCHED
}
}
#define GAS __attribute__((address_space(1)))
#define LAS __attribute__((address_space(3)))
typedef unsigned short bf16;
typedef unsigned v4u __attribute__((ext_vector_type(4)));
typedef float f32x4 __attribute__((ext_vector_type(4)));
typedef short bf16x8 __attribute__((ext_vector_type(8)));
typedef GAS unsigned gu32;
typedef GAS unsigned long long gu64;
#define RLX_AGENT __ATOMIC_RELAXED, __HIP_MEMORY_SCOPE_AGENT
#define LDS_WAIT() asm volatile("s_waitcnt lgkmcnt(0)" ::: "memory")
#define VM_WAIT() asm volatile("s_waitcnt vmcnt(0)" ::: "memory")
__device__ __forceinline__ unsigned long long rt() { return __builtin_amdgcn_s_memrealtime(); }
__device__ __forceinline__ unsigned f2bf(float f) { unsigned u = __builtin_bit_cast(unsigned, f); return (u + 0x7fffu + ((u >> 16) & 1u)) >> 16; }
__device__ __forceinline__ unsigned pk2(float lo, float hi) { return f2bf(lo) | (f2bf(hi) << 16); }

#define XB_TMO      128
#define XB_XCNT(j)  (256  + 64 * (j))
#define XB_XSUB(j)  (1280 + 64 * (j))
#define XB_XGEN(j)  (2304 + 64 * (j))
#define XB_TOP      3328
#define XB_TOPGEN   3392
#define XCD_BAR_WORDS 3456
#define XB_SPIN_CAP (1u << 18)

__device__ __forceinline__ unsigned xb_ld(unsigned* p)              { return __hip_atomic_load(p, __ATOMIC_RELAXED, __HIP_MEMORY_SCOPE_AGENT); }
__device__ __forceinline__ unsigned xb_add(unsigned* p, unsigned v) { return __hip_atomic_fetch_add(p, v, __ATOMIC_RELAXED, __HIP_MEMORY_SCOPE_AGENT); }
__device__ __forceinline__ unsigned xb_xcc_id() { return (unsigned)__builtin_amdgcn_s_getreg((3 << 11) | 20) & 0xFu; }
#define XB_SPIN(cond, bar) do { unsigned _sp = 0; while (cond) { __builtin_amdgcn_s_sleep(1); \
    if ((++_sp & 255u) == 0u) { if (xb_ld(&(bar)[XB_TMO])) break; if (_sp > XB_SPIN_CAP) { atomicAdd(&(bar)[XB_TMO], 1u); break; } } } } while (0)

struct XcdBarrier {
    unsigned* bar; unsigned x;
    volatile LAS unsigned* st;
};

__device__ __forceinline__ XcdBarrier xcd_barrier_post(unsigned* bar, volatile LAS unsigned* st) {
    XcdBarrier b; b.bar = bar; b.x = xb_xcc_id(); b.st = st;
    if (threadIdx.x == 0) (void)xb_add(&bar[XB_XCNT(b.x)], 1u);
    return b;
}
__device__ __forceinline__ void xcd_barrier_complete(unsigned* bar, unsigned x, unsigned& nloc, unsigned& nx) {
    const unsigned G = gridDim.x * gridDim.y * gridDim.z;
    unsigned sum, cnt, mine, sp = 0u;
    for (;;) {
        sum = 0u; cnt = 0u; mine = 0u;
#pragma unroll
        for (unsigned j = 0; j < 16; ++j) { const unsigned c = xb_ld(&bar[XB_XCNT(j)]); sum += c; cnt += (c > 0u) ? 1u : 0u; mine = (j == x) ? c : mine; }
        if (sum == G) break;
        __builtin_amdgcn_s_sleep(1);
        if ((++sp & 255u) == 0u) { if (xb_ld(&bar[XB_TMO])) break; if (sp > XB_SPIN_CAP) { atomicAdd(&bar[XB_TMO], 1u); break; } }
    }
    nloc = mine > 0u ? mine : 1u; nx = cnt > 0u ? cnt : 1u;
}

__device__ __forceinline__ void xcd_barrier(const XcdBarrier& b) {
    asm volatile("s_waitcnt vmcnt(0)" ::: "memory");
    __syncthreads();
    if (threadIdx.x == 0) {
        unsigned* bar = b.bar;
        __builtin_amdgcn_s_waitcnt(0);
        unsigned nloc = b.st[0], nx = b.st[1];
        if (nloc == 0u) { xcd_barrier_complete(bar, b.x, nloc, nx); b.st[0] = nloc; b.st[1] = nx; }
        const unsigned old = xb_add(&bar[XB_XSUB(b.x)], 1u);
        const unsigned gen = old / nloc;
        if (old + 1u == (gen + 1u) * nloc) {
            __builtin_amdgcn_fence(__ATOMIC_RELEASE, "agent");
            asm volatile("s_waitcnt vmcnt(0)" ::: "memory");
            const unsigned og = xb_add(&bar[XB_TOP], 1u);
            const unsigned tg = og / nx;
            if (og + 1u == (tg + 1u) * nx) xb_add(&bar[XB_TOPGEN], 1u);
            else XB_SPIN(xb_ld(&bar[XB_TOPGEN]) == tg, bar);
            __builtin_amdgcn_fence(__ATOMIC_ACQUIRE, "agent");
            xb_add(&bar[XB_XGEN(b.x)], 1u);
            asm volatile("s_waitcnt vmcnt(0)" ::: "memory");
        } else {
            XB_SPIN(xb_ld(&bar[XB_XGEN(b.x)]) == gen, bar);
            __builtin_amdgcn_fence(__ATOMIC_ACQUIRE, "agent");
            asm volatile("s_waitcnt vmcnt(0)" ::: "memory");
        }
    }
    __syncthreads();
}
constexpr int NB = 16, S = 2048, D = 1024, M = NB * S, DEPTH = 4, H = 16, HD = 64, DFF = 2816;
constexpr int A_IN = 1280, B_IN = 2608, B_INP = 2816, C_IN = 3072;
constexpr float NORM_EPS = 1e-6f;
constexpr float NEGF = -1e30f;
constexpr float LOG2E = 1.4426950408889634f;
constexpr int NWAVES = 8;

constexpr size_t MiB = 1u << 20;
constexpr size_t WS_CTL = 0, CTL_ZERO_BYTES = 1 * MiB;
constexpr size_t WS_LUTG = 1 * MiB;
constexpr size_t WS_BIAS1 = WS_LUTG + 131072;
constexpr size_t WS_W2T = WS_BIAS1 + 4096;
constexpr size_t WS_KCB = 2 * MiB, WS_VCB = 3 * MiB;
constexpr size_t WS_WFI = 4 * MiB;
constexpr size_t WS_WFO = 92 * MiB;
constexpr size_t WS_WAI = 136 * MiB;
constexpr size_t WS_WAO = 141 * MiB;
constexpr size_t WS_WBI = 145 * MiB;
constexpr size_t WS_WBO = 151 * MiB;
constexpr size_t WS_WC1 = 153 * MiB;
constexpr size_t WS_WCI = 155 * MiB;
constexpr size_t WS_WCO = 161 * MiB;
constexpr size_t WS_HN = 164 * MiB, WS_Y = 228 * MiB, WS_O = 292 * MiB, WS_BIG = 356 * MiB, WS_KMEAN = 548 * MiB, WS_END = 552 * MiB;
constexpr int CW_BAR = 4096;

constexpr int RING_OFF = 0, RING_BYTES = 131072;
constexpr int LDSCTL_OFF = RING_BYTES, MISC_OFF = LDSCTL_OFF + 320;
constexpr int LDS_BYTES = 147456;

__device__ __forceinline__ float bf2f(bf16 v) { return __uint_as_float(((unsigned)v) << 16); }
__device__ __forceinline__ float bflo(unsigned w) { return __uint_as_float(w << 16); }
__device__ __forceinline__ float bfhi(unsigned w) { return __uint_as_float(w & 0xffff0000u); }
__device__ __forceinline__ float wave_sum(float v) {
#pragma unroll
    for (int o = 1; o < 64; o <<= 1) v += __shfl_xor(v, o);
    return v;
}
__device__ __forceinline__ float wave_max(float v) {
#pragma unroll
    for (int o = 1; o < 64; o <<= 1) v = fmaxf(v, __shfl_xor(v, o));
    return v;
}
__host__ __device__ __forceinline__ int rel_bucket(int d) {
    if (d < 16) return d < 0 ? 0 : d;
    return 16 + (d >= 21) + (d >= 27) + (d >= 35) + (d >= 46) + (d >= 59) + (d >= 77) + (d >= 99) + (d >= 128) + (d >= 166) + (d >= 216) + (d >= 280) + (d >= 363) + (d >= 470) + (d >= 609) + (d >= 790);
}

template <int MODE> __device__ __forceinline__ void conv_w(const float* W, int nmat, int K, int N, int NP, bf16* dst, LAS float* scr, int gw, int NGW, int lane) {
    const int nblk = (N + 31) / 32, kblk = K / 64, per = nblk * kblk, total = nmat * per;
    for (int it = gw; it < total; it += NGW) {
        const int mat = it / per, r = it % per, kb = r / nblk, nb = r % nblk, k0 = 64 * kb, n0 = 32 * nb;
        const float* Wm = W + (size_t)mat * K * N; bf16* Dm = dst + (size_t)mat * NP * K;
        const int ncol = n0 + (lane & 31); const bool ok = ncol < N;
#pragma unroll 8
        for (int i = 0; i < 32; ++i) { const int kk = 2 * i + (lane >> 5); scr[kk * 33 + (lane & 31)] = ok ? Wm[(size_t)(k0 + kk) * N + ncol] : 0.f; }
        LDS_WAIT(); asm volatile("" ::: "memory");
        const int c = lane & 7;
#pragma unroll
        for (int j = 0; j < 4; ++j) { const int n = (lane >> 3) + 8 * j; const int nn = n0 + n; const LAS float* s = scr + (8 * c) * 33 + n;
            v4u o; o.x = pk2(s[0 * 33], s[1 * 33]); o.y = pk2(s[2 * 33], s[3 * 33]); o.z = pk2(s[4 * 33], s[5 * 33]); o.w = pk2(s[6 * 33], s[7 * 33]);
            int row = nn;
            if (MODE == 1) { const int hf = nn >= DFF ? 1 : 0, jj = nn - hf * DFF; row = 256 * (jj >> 7) + 128 * hf + (jj & 127); }
            if (nn < N) *(GAS v4u*)(Dm + (size_t)row * K + k0 + 8 * c) = o; }
        LDS_WAIT(); asm volatile("" ::: "memory");
    }
}
__device__ __forceinline__ void norm_row(const float* xrow, const float* g, bf16* orow, int lane) {
    f32x4 v[4]; float s = 0.f;
#pragma unroll
    for (int j = 0; j < 4; ++j) { v[j] = *(const GAS f32x4*)(xrow + 256 * j + 4 * lane); s += (v[j].x * v[j].x + v[j].y * v[j].y) + (v[j].z * v[j].z + v[j].w * v[j].w); }
    const float r = 1.0f / sqrtf(wave_sum(s) * (1.f / D) + NORM_EPS);
#pragma unroll
    for (int j = 0; j < 4; ++j) { const f32x4 gg = *(const GAS f32x4*)(g + 256 * j + 4 * lane);
        const unsigned lo = pk2(v[j].x * r * gg.x, v[j].y * r * gg.y), hi = pk2(v[j].z * r * gg.z, v[j].w * r * gg.w);
        *(GAS unsigned long long*)(orow + 256 * j + 4 * lane) = (unsigned long long)lo | ((unsigned long long)hi << 32); }
}
__device__ __forceinline__ void thin_phase(const float* xin, float* xout, const bf16* y, bf16* hn, const float* gpost, const float* gpre, float c, int gw, int NGW, int lane) {
    asm volatile("" : "+v"(lane));
    float gp[16], gq[16];
#pragma unroll
    for (int j = 0; j < 2; ++j)
#pragma unroll
        for (int e = 0; e < 8; ++e) { gp[j * 8 + e] = gpost[j * 512 + lane * 8 + e] * c; gq[j * 8 + e] = gpre ? gpre[j * 512 + lane * 8 + e] : 0.f; }
    for (int m = gw; m < M; m += NGW) {
        const bf16* yr = y + (size_t)m * D; const float* xr = xin + (size_t)m * D;
        float yv[16], xv[16]; float s = 0.f;
#pragma unroll
        for (int j = 0; j < 2; ++j) { const v4u w = *(const GAS v4u*)(yr + j * 512 + lane * 8);
            yv[j * 8 + 0] = bflo(w.x); yv[j * 8 + 1] = bfhi(w.x); yv[j * 8 + 2] = bflo(w.y); yv[j * 8 + 3] = bfhi(w.y); yv[j * 8 + 4] = bflo(w.z); yv[j * 8 + 5] = bfhi(w.z); yv[j * 8 + 6] = bflo(w.w); yv[j * 8 + 7] = bfhi(w.w);
            const f32x4 a = *(const GAS f32x4*)(xr + j * 512 + lane * 8), b = *(const GAS f32x4*)(xr + j * 512 + lane * 8 + 4);
            xv[j * 8 + 0] = a.x; xv[j * 8 + 1] = a.y; xv[j * 8 + 2] = a.z; xv[j * 8 + 3] = a.w; xv[j * 8 + 4] = b.x; xv[j * 8 + 5] = b.y; xv[j * 8 + 6] = b.z; xv[j * 8 + 7] = b.w; }
#pragma unroll
        for (int e = 0; e < 16; ++e) s += yv[e] * yv[e];
        const float ry = 1.0f / sqrtf(wave_sum(s) * (1.f / D) + NORM_EPS);
        float s2 = 0.f;
#pragma unroll
        for (int e = 0; e < 16; ++e) { xv[e] = xv[e] + yv[e] * ry * gp[e]; s2 += xv[e] * xv[e]; }
        float* xo = xout + (size_t)m * D;
#pragma unroll
        for (int j = 0; j < 2; ++j) { *(GAS f32x4*)(xo + j * 512 + lane * 8) = (f32x4){xv[j * 8 + 0], xv[j * 8 + 1], xv[j * 8 + 2], xv[j * 8 + 3]};
            *(GAS f32x4*)(xo + j * 512 + lane * 8 + 4) = (f32x4){xv[j * 8 + 4], xv[j * 8 + 5], xv[j * 8 + 6], xv[j * 8 + 7]}; }
        if (gpre) {
            const float rx = 1.0f / sqrtf(wave_sum(s2) * (1.f / D) + NORM_EPS);
            bf16* ho = hn + (size_t)m * D;
#pragma unroll
            for (int j = 0; j < 2; ++j) { v4u o; o.x = pk2(xv[j * 8 + 0] * rx * gq[j * 8 + 0], xv[j * 8 + 1] * rx * gq[j * 8 + 1]); o.y = pk2(xv[j * 8 + 2] * rx * gq[j * 8 + 2], xv[j * 8 + 3] * rx * gq[j * 8 + 3]);
                o.z = pk2(xv[j * 8 + 4] * rx * gq[j * 8 + 4], xv[j * 8 + 5] * rx * gq[j * 8 + 5]); o.w = pk2(xv[j * 8 + 6] * rx * gq[j * 8 + 6], xv[j * 8 + 7] * rx * gq[j * 8 + 7]);
                *(GAS v4u*)(ho + j * 512 + lane * 8) = o; }
        }
    }
}
typedef float f32x16 __attribute__((ext_vector_type(16)));
typedef short s16x4 __attribute__((ext_vector_type(4)));
typedef float f32x2_t __attribute__((ext_vector_type(2)));
typedef __bf16 bf16x2_t __attribute__((ext_vector_type(2)));
#define MFMA32(a, b, c) __builtin_amdgcn_mfma_f32_32x32x16_bf16((a), (b), (c), 0, 0, 0)
__device__ __forceinline__ unsigned cvtpk(float lo, float hi) { f32x2_t v = {lo, hi}; bf16x2_t b = __builtin_convertvector(v, bf16x2_t); return __builtin_bit_cast(unsigned, b); }
__device__ __forceinline__ float ex2(float x) { return __builtin_amdgcn_exp2f(x); }
constexpr int KT_PITCH = 144, KT_BYTES = 64 * KT_PITCH, VT_BYTES = 8192;
constexpr int ATT_K0 = 0, ATT_V0 = 2 * KT_BYTES, ATT_LUT = ATT_V0 + 2 * VT_BYTES;
constexpr int LUT_PAD = 192;
constexpr float M_INIT = -5e29f;
struct TileRegs { v4u k, v; };
__device__ __forceinline__ void tile_gload(TileRegs& t, const bf16* kg, const bf16* vg, int pitchk, int pitchv, int tid) {
    const int row = tid >> 3, ch = tid & 7;
    t.k = *(const GAS v4u*)(kg + (size_t)row * pitchk + ch * 8);
    t.v = *(const GAS v4u*)(vg + (size_t)row * pitchv + ch * 8);
}
__device__ __forceinline__ void tile_swrite(const TileRegs& t, LAS unsigned char* kt, LAS unsigned char* vt, int tid) {
    const int row = tid >> 3, ch = tid & 7;
    *(LAS v4u*)(kt + row * KT_PITCH + ch * 16) = t.k;
    *(LAS v4u*)(vt + (ch >> 2) * 4096 + row * 64 + (ch & 3) * 16) = t.v;
}
__device__ __forceinline__ void tile_qk(const LAS unsigned char* kt, const bf16x8 (&qf)[4], f32x16& p0, f32x16& p1, int lane) {
    const LAS unsigned char* kp = kt + (lane & 31) * KT_PITCH + (lane >> 5) * 16;
#pragma unroll
    for (int r = 0; r < 16; ++r) { p0[r] = 0.f; p1[r] = 0.f; }
#pragma unroll
    for (int ks = 0; ks < 4; ++ks) {
        const bf16x8 a0 = *(const LAS bf16x8*)(kp + ks * 32), a1 = *(const LAS bf16x8*)(kp + 32 * KT_PITCH + ks * 32);
        p0 = MFMA32(a0, qf[ks], p0); p1 = MFMA32(a1, qf[ks], p1);
    }
}
__device__ __forceinline__ s16x4 vtr(const LAS unsigned char* p) { return __builtin_bit_cast(s16x4, __builtin_amdgcn_ds_read_tr16_b64_v4i16((LAS s16x4*)p)); }
__device__ __forceinline__ void tile_pv(const LAS unsigned char* vt, const f32x16& p0, const f32x16& p1, f32x16& o0, f32x16& o1, int lane) {
    const int hi = lane >> 5;
    const LAS unsigned char* vb = vt + ((lane >> 4) & 1) * 32 + (lane & 3) * 8 + (4 * hi + ((lane & 15) >> 2)) * 64;
#pragma unroll
    for (int ph = 0; ph < 2; ++ph)
#pragma unroll
        for (int s = 0; s < 2; ++s) {
            v4u w;
            if (ph == 0) { w.x = cvtpk(p0[8 * s + 0], p0[8 * s + 1]); w.y = cvtpk(p0[8 * s + 2], p0[8 * s + 3]); w.z = cvtpk(p0[8 * s + 4], p0[8 * s + 5]); w.w = cvtpk(p0[8 * s + 6], p0[8 * s + 7]); }
            else         { w.x = cvtpk(p1[8 * s + 0], p1[8 * s + 1]); w.y = cvtpk(p1[8 * s + 2], p1[8 * s + 3]); w.z = cvtpk(p1[8 * s + 4], p1[8 * s + 5]); w.w = cvtpk(p1[8 * s + 6], p1[8 * s + 7]); }
            const bf16x8 pf = __builtin_bit_cast(bf16x8, w);
            const int ks = 2 * ph + s;
            { const s16x4 lo = vtr(vb + ks * 1024), h2 = vtr(vb + ks * 1024 + 512);
              const bf16x8 vf = (bf16x8){lo[0], lo[1], lo[2], lo[3], h2[0], h2[1], h2[2], h2[3]}; o0 = MFMA32(vf, pf, o0); }
            { const s16x4 lo = vtr(vb + 4096 + ks * 1024), h2 = vtr(vb + 4096 + ks * 1024 + 512);
              const bf16x8 vf = (bf16x8){lo[0], lo[1], lo[2], lo[3], h2[0], h2[1], h2[2], h2[3]}; o1 = MFMA32(vf, pf, o1); }
        }
}
__device__ __forceinline__ void tile_softmax(f32x16& p0, f32x16& p1, const LAS float* rl, float sc, float& m, float& l, f32x16& o0, f32x16& o1) {
#pragma unroll
    for (int r = 0; r < 16; ++r) { const int c = 8 * (r >> 2) + (r & 3); p0[r] = fmaf(p0[r], sc, rl[c]); p1[r] = fmaf(p1[r], sc, rl[32 + c]); }
    float mx = fmaxf(p0[0], p1[0]);
#pragma unroll
    for (int r = 1; r < 16; ++r) mx = fmaxf(mx, fmaxf(p0[r], p1[r]));
    mx = fmaxf(mx, __shfl_xor(mx, 32));
    const float mn = fmaxf(m, mx), alpha = ex2(m - mn); m = mn;
    float ls = 0.f;
#pragma unroll
    for (int r = 0; r < 16; ++r) { p0[r] = ex2(p0[r] - mn); p1[r] = ex2(p1[r] - mn); ls += p0[r] + p1[r]; }
    l = l * alpha + ls;
    if (!__all(alpha == 1.0f)) {
#pragma unroll
        for (int r = 0; r < 16; ++r) { o0[r] *= alpha; o1[r] *= alpha; }
    }
}
__device__ __forceinline__ void load_qf(bf16x8 (&qf)[4], const bf16* qrow, int hi) {
#pragma unroll
    for (int ks = 0; ks < 4; ++ks) qf[ks] = *(const GAS bf16x8*)(qrow + 16 * ks + 8 * hi);
}
__device__ __forceinline__ void store_o(bf16* orow, const f32x16& o0, const f32x16& o1, int hi) {
#pragma unroll
    for (int a = 0; a < 4; ++a) {
        const unsigned long long w0 = (unsigned long long)cvtpk(o0[4 * a + 0], o0[4 * a + 1]) | ((unsigned long long)cvtpk(o0[4 * a + 2], o0[4 * a + 3]) << 32);
        const unsigned long long w1 = (unsigned long long)cvtpk(o1[4 * a + 0], o1[4 * a + 1]) | ((unsigned long long)cvtpk(o1[4 * a + 2], o1[4 * a + 3]) << 32);
        *(GAS unsigned long long*)(orow + 8 * a + 4 * hi) = w0; *(GAS unsigned long long*)(orow + 32 + 8 * a + 4 * hi) = w1;
    }
}
constexpr float SC_LOG2 = 0.125f * LOG2E;
__device__ __forceinline__ void attn_phase_A(LAS unsigned char* L, const bf16* qkv, const float* lutg, const float* sinks, bf16* O, int G) {
    constexpr int DMAX = 191, LUTN = DMAX + 1 + LUT_PAD;
    LAS float* lut = (LAS float*)(L + ATT_LUT);
    for (int u = blockIdx.x; u < 2048; u += G) {
        int tid_ = threadIdx.x; asm volatile("" : "+v"(tid_));
        const int tid = tid_, lane = tid & 63, wave = __builtin_amdgcn_readfirstlane(tid >> 6), r32 = lane & 31, hi = lane >> 5;
        const int c = u & 31, hq = (u >> 5) & 1, g = (u >> 6) & 1, b = u >> 7;
        for (int i = tid; i < 4 * LUTN; i += 512) { const int hh = i / LUTN, k = i - hh * LUTN, dist = DMAX - k, h = 8 * g + 4 * hq + hh;
            lut[i] = (dist < 0 || dist >= 128) ? NEGF : lutg[h * 2048 + dist] * LOG2E; }
        const int hl = wave >> 1, h = 8 * g + 4 * hq + hl, tq = 64 * c + 32 * (wave & 1) + r32;
        const size_t tokq = (size_t)b * S + tq;
        bf16x8 qf[4]; load_qf(qf, qkv + tokq * A_IN + h * 64, hi);
        float m = M_INIT, l = 0.f; f32x16 o0, o1;
#pragma unroll
        for (int r = 0; r < 16; ++r) { o0[r] = 0.f; o1[r] = 0.f; }
        const bf16* kbase = qkv + (size_t)b * S * A_IN + 1024 + g * 64; const bf16* vbase = kbase + 128;
        const int kt0 = c >= 2 ? c - 2 : 0, n = c - kt0 + 1;
        TileRegs tr; tile_gload(tr, kbase + (size_t)(64 * kt0) * A_IN, vbase + (size_t)(64 * kt0) * A_IN, A_IN, A_IN, tid);
        tile_swrite(tr, L + ATT_K0, L + ATT_V0, tid);
        __syncthreads();
        for (int i = 0; i < n; ++i) {
            const int buf = i & 1, kt = kt0 + i;
            if (i + 1 < n) tile_gload(tr, kbase + (size_t)(64 * (kt + 1)) * A_IN, vbase + (size_t)(64 * (kt + 1)) * A_IN, A_IN, A_IN, tid);
            { f32x16 p0, p1; tile_qk(L + ATT_K0 + buf * KT_BYTES, qf, p0, p1, lane);
              const LAS float* rl = lut + hl * LUTN + (DMAX - tq + 64 * kt + 4 * hi);
              tile_softmax(p0, p1, rl, SC_LOG2, m, l, o0, o1);
              tile_pv(L + ATT_V0 + buf * VT_BYTES, p0, p1, o0, o1, lane); }
            if (i + 1 < n) tile_swrite(tr, L + ATT_K0 + (buf ^ 1) * KT_BYTES, L + ATT_V0 + (buf ^ 1) * VT_BYTES, tid);
            __syncthreads();
        }
        const float lt = l + __shfl_xor(l, 32);
        const float inv = 1.0f / (lt + ex2(sinks[h] * LOG2E - m));
#pragma unroll
        for (int r = 0; r < 16; ++r) { o0[r] *= inv; o1[r] *= inv; }
        store_o(O + tokq * D + h * 64, o0, o1, hi);
    }
}
__device__ __forceinline__ void attn_phase_C(LAS unsigned char* L, const bf16* qkv, const float* lutg, bf16* O, int G) {
    constexpr int DMAX = 2047, LUTN = DMAX + 1 + LUT_PAD;
    LAS float* lut = (LAS float*)(L + ATT_LUT);
    LAS float* KM = (LAS float*)(L + ATT_LUT + 9216);
    LAS float* PART = KM + 512;
    for (int bh = blockIdx.x; bh < 256; bh += G) {
        const int b = bh >> 4, h = bh & 15;
        for (int i = threadIdx.x; i < LUTN; i += 512) { const int dist = DMAX - i; lut[i] = dist < 0 ? NEGF : lutg[h * 2048 + dist] * LOG2E; }
        const bf16* kbase = qkv + (size_t)b * S * C_IN + 1024 + h * 64; const bf16* vbase = kbase + 1024;
        for (int c = 0; c < 8; ++c) {
            int tid_ = threadIdx.x; asm volatile("" : "+v"(tid_));
            const int tid = tid_, lane = tid & 63, wave = __builtin_amdgcn_readfirstlane(tid >> 6), r32 = lane & 31, hi = lane >> 5;
            const int tq = 256 * c + 32 * wave + r32; const size_t tokq = (size_t)b * S + tq;
            bf16x8 qf[4]; load_qf(qf, qkv + tokq * C_IN + h * 64, hi);
            unsigned selm = 0u;
            if (c > 0) {
                float gv[7];
#pragma unroll
                for (int n = 0; n < 7; ++n) {
                    float s = -3e38f;
                    if (n < c) { s = 0.f;
#pragma unroll
                        for (int ks = 0; ks < 4; ++ks)
#pragma unroll
                            for (int j = 0; j < 8; ++j) s += bf2f((bf16)qf[ks][j]) * KM[n * 64 + 16 * ks + 8 * hi + j];
                        s += __shfl_xor(s, 32); }
                    gv[n] = s; }
                if (c <= 3) selm = (1u << c) - 1u;
                else {
#pragma unroll
                    for (int rnd = 0; rnd < 3; ++rnd) { int best = 0; float bv = gv[0];
#pragma unroll
                        for (int n = 1; n < 7; ++n) if (gv[n] > bv) { bv = gv[n]; best = n; }
                        selm |= 1u << best;
#pragma unroll
                        for (int n = 0; n < 7; ++n) gv[n] = (n == best) ? -3e38f : gv[n]; }
                }
            }
            float m = M_INIT, l = 0.f; f32x16 o0, o1;
#pragma unroll
            for (int r = 0; r < 16; ++r) { o0[r] = 0.f; o1[r] = 0.f; }
            float cs[8];
#pragma unroll
            for (int j = 0; j < 8; ++j) cs[j] = 0.f;
#define CS_ACC(t) do { cs[0] += bflo((t).k.x); cs[1] += bfhi((t).k.x); cs[2] += bflo((t).k.y); cs[3] += bfhi((t).k.y); cs[4] += bflo((t).k.z); cs[5] += bfhi((t).k.z); cs[6] += bflo((t).k.w); cs[7] += bfhi((t).k.w); } while (0)
            const int n = 4 + 4 * c;
            TileRegs tr; tile_gload(tr, kbase + (size_t)(256 * c) * C_IN, vbase + (size_t)(256 * c) * C_IN, C_IN, C_IN, tid);
            CS_ACC(tr);
            tile_swrite(tr, L + ATT_K0, L + ATT_V0, tid);
            __syncthreads();
            for (int i = 0; i < n; ++i) {
                const int buf = i & 1, kt = i < 4 ? 4 * c + i : i - 4;
                const int i2 = i + 1, kt2 = i2 < 4 ? 4 * c + i2 : i2 - 4;
                if (i2 < n) tile_gload(tr, kbase + (size_t)(64 * kt2) * C_IN, vbase + (size_t)(64 * kt2) * C_IN, C_IN, C_IN, tid);
                const bool need = i < 4 ? (i <= (wave >> 1)) : true;
                if (need) {
                    const bool lsel = i < 4 ? true : (((selm >> ((i - 4) >> 2)) & 1u) != 0u);
                    f32x16 p0, p1; tile_qk(L + ATT_K0 + buf * KT_BYTES, qf, p0, p1, lane);
                    const LAS float* rl = lut + (lsel ? (DMAX - tq + 64 * kt + 4 * hi) : (DMAX + 64));
                    tile_softmax(p0, p1, rl, SC_LOG2, m, l, o0, o1);
                    tile_pv(L + ATT_V0 + buf * VT_BYTES, p0, p1, o0, o1, lane); }
                if (i2 < n) { if (i2 < 4) CS_ACC(tr); tile_swrite(tr, L + ATT_K0 + (buf ^ 1) * KT_BYTES, L + ATT_V0 + (buf ^ 1) * VT_BYTES, tid); }
                __syncthreads();
            }
#undef CS_ACC
#pragma unroll
            for (int j = 0; j < 8; ++j) { float v = cs[j]; v += __shfl_xor(v, 8); v += __shfl_xor(v, 16); v += __shfl_xor(v, 32); cs[j] = v; }
            if (lane < 8) {
#pragma unroll
                for (int j = 0; j < 8; ++j) PART[wave * 64 + lane * 8 + j] = cs[j]; }
            __syncthreads();
            if (tid < 64) { float s = 0.f;
#pragma unroll
                for (int w = 0; w < 8; ++w) s += PART[w * 64 + tid];
                KM[c * 64 + tid] = s; }
            __syncthreads();
            const float lt = l + __shfl_xor(l, 32);
            const float inv = 1.0f / lt;
#pragma unroll
            for (int r = 0; r < 16; ++r) { o0[r] *= inv; o1[r] *= inv; }
            store_o(O + tokq * D + h * 64, o0, o1, hi);
        }
    }
}
__device__ __forceinline__ float gelu_tanh(float x) {
    const float z = 0.7978845608028654f * (x + 0.044715f * x * x * x);
    const float e = ex2(2.0f * LOG2E * z);
    const float t = 1.0f - 2.0f * __builtin_amdgcn_rcpf(1.0f + e);
    return 0.5f * x * (1.0f + t);
}
__device__ __forceinline__ void compress_phase(LAS unsigned char* L, const bf16* qkv, const bf16* w1t, const bf16* w2t, const float* bias1, bf16* kcb, bf16* vcb, int G) {
    constexpr int AP = 144, HP = 528;
    LAS unsigned char* AT = L; LAS unsigned char* H1 = L + 2 * 64 * AP;
    for (int u = blockIdx.x; u < 256; u += G) {
        int tid_ = threadIdx.x; asm volatile("" : "+v"(tid_));
        const int tid = tid_, lane = tid & 63, wave = __builtin_amdgcn_readfirstlane(tid >> 6), r32 = lane & 31, hi = lane >> 5;
        const int nh = u & 1, kv = (u >> 1) & 1, g = (u >> 2) & 3, b = u >> 4;
        const int arow = tid >> 3, ach = tid & 7; int n_ld = 64 * nh + arow; if (n_ld > 126) n_ld = 126;
        const bf16* abase = qkv + ((size_t)b * S + 16 * n_ld) * B_INP + 1024 + kv * 256 + g * 64 + 8 * ach;
        const bf16* bbase = w1t + ((size_t)kv * 256 + 32 * wave + r32) * 2048 + 8 * hi;
        f32x16 acc0, acc1;
#pragma unroll
        for (int r = 0; r < 16; ++r) { acc0[r] = 0.f; acc1[r] = 0.f; }
        v4u areg = *(const GAS v4u*)abase; bf16x8 breg[4];
#pragma unroll
        for (int ks = 0; ks < 4; ++ks) breg[ks] = *(const GAS bf16x8*)(bbase + 16 * ks);
        *(LAS v4u*)(AT + arow * AP + ach * 16) = areg;
        __syncthreads();
        for (int l = 0; l < 32; ++l) {
            const int buf = l & 1; v4u an = areg; bf16x8 bn[4];
#pragma unroll
            for (int ks = 0; ks < 4; ++ks) bn[ks] = breg[ks];
            if (l + 1 < 32) { an = *(const GAS v4u*)(abase + (size_t)(l + 1) * B_INP);
#pragma unroll
                for (int ks = 0; ks < 4; ++ks) bn[ks] = *(const GAS bf16x8*)(bbase + (l + 1) * 64 + 16 * ks); }
            const LAS unsigned char* ap = AT + buf * 64 * AP + r32 * AP + hi * 16;
#pragma unroll
            for (int ks = 0; ks < 4; ++ks) { const bf16x8 a0 = *(const LAS bf16x8*)(ap + ks * 32), a1 = *(const LAS bf16x8*)(ap + 32 * AP + ks * 32);
                acc0 = MFMA32(a0, breg[ks], acc0); acc1 = MFMA32(a1, breg[ks], acc1); }
            if (l + 1 < 32) *(LAS v4u*)(AT + (buf ^ 1) * 64 * AP + arow * AP + ach * 16) = an;
#pragma unroll
            for (int ks = 0; ks < 4; ++ks) breg[ks] = bn[ks];
            __syncthreads();
        }
        const float bias = bias1[kv * 256 + 32 * wave + r32];
#pragma unroll
        for (int r = 0; r < 16; ++r) { const int row = (r & 3) + 8 * (r >> 2) + 4 * hi;
            *(LAS bf16*)(H1 + row * HP + (32 * wave + r32) * 2) = (bf16)f2bf(gelu_tanh(acc0[r] + bias));
            *(LAS bf16*)(H1 + (row + 32) * HP + (32 * wave + r32) * 2) = (bf16)f2bf(gelu_tanh(acc1[r] + bias)); }
        __syncthreads();
        if (wave < 4) { const int rt = wave >> 1, ct = wave & 1; f32x16 acc;
#pragma unroll
            for (int r = 0; r < 16; ++r) acc[r] = 0.f;
#pragma unroll 4
            for (int ks = 0; ks < 16; ++ks) { const bf16x8 a = *(const LAS bf16x8*)(H1 + (32 * rt + r32) * HP + (16 * ks + 8 * hi) * 2);
                const bf16x8 bb = *(const GAS bf16x8*)(w2t + ((size_t)kv * 64 + 32 * ct + r32) * 256 + 16 * ks + 8 * hi); acc = MFMA32(a, bb, acc); }
            bf16* dst = (kv ? vcb : kcb) + (size_t)(b * 4 + g) * 128 * 64;
#pragma unroll
            for (int r = 0; r < 16; ++r) { const int n = 64 * nh + 32 * rt + (r & 3) + 8 * (r >> 2) + 4 * hi;
                dst[(size_t)n * 64 + 32 * ct + r32] = n < 127 ? (bf16)f2bf(acc[r]) : (bf16)0; } }
        __syncthreads();
    }
}
__device__ __forceinline__ void attn_phase_B(LAS unsigned char* L, const bf16* qkv, const float* lutg, const bf16* kcb, const bf16* vcb, bf16* O, int G) {
    int tid0_ = threadIdx.x; asm volatile("" : "+v"(tid0_));
    const int tid0 = tid0_;
    constexpr int DS = 2047, LS = DS + 1 + LUT_PAD, DW = 575, LW = DW + 1 + LUT_PAD;
    LAS float* lutS = (LAS float*)(L + ATT_LUT);
    LAS float* lutW = lutS + 4 * LS;
    LAS float* IMPH = lutW + 4 * LW;
    LAS unsigned* SEL = (LAS unsigned*)(IMPH + 4 * 64 * 32);
    LAS unsigned* UNI = SEL + 64;
    LAS unsigned char* const K0 = L + ATT_K0; LAS unsigned char* const V0 = L + ATT_V0;
    for (int v = blockIdx.x; v < 256; v += G) {
        const int bg = v >> 2, jq = v & 3, b = bg >> 2, g = bg & 3;
        for (int i = tid0; i < 4 * LS; i += 512) { const int hh = i / LS, k = i - hh * LS, dist = DS - k; lutS[i] = dist < 0 ? NEGF : lutg[(4 * g + hh) * 2048 + dist] * LOG2E; }
        for (int i = tid0; i < 4 * LW; i += 512) { const int hh = i / LW, k = i - hh * LW, dist = DW - k; lutW[i] = (dist < 0 || dist >= 512) ? NEGF : lutg[(4 * g + hh) * 2048 + dist] * LOG2E; }
        const bf16* kc = kcb + (size_t)bg * 128 * 64; const bf16* vc = vcb + (size_t)bg * 128 * 64;
        const bf16* rowb = qkv + (size_t)b * S * B_INP;
        for (int ci = 0; ci < 8; ++ci) {
            int tid_ = threadIdx.x; asm volatile("" : "+v"(tid_));
            const int tid = tid_, lane = tid & 63, wave = __builtin_amdgcn_readfirstlane(tid >> 6), r32 = lane & 31, hi = lane >> 5;
            const int pr = ci >> 1, cb = pr == 0 ? jq : (pr == 1 ? 7 - jq : (pr == 2 ? 8 + jq : 15 - jq)), c = (ci & 1) ? 31 - cb : cb;
            const int hl = wave >> 1, h = 4 * g + hl, tl = 32 * (wave & 1) + r32, tq = 64 * c + tl;
            const size_t tokq = (size_t)b * S + tq;
            bf16x8 qf[4]; load_qf(qf, qkv + tokq * B_INP + h * 64, hi);
            float gt0, gt1, gt2;
            { const bf16* gp = qkv + tokq * B_INP + 2560 + h * 3;
              gt0 = __builtin_amdgcn_rcpf(1.f + ex2(-LOG2E * bf2f(gp[0]))); gt1 = __builtin_amdgcn_rcpf(1.f + ex2(-LOG2E * bf2f(gp[1]))); gt2 = __builtin_amdgcn_rcpf(1.f + ex2(-LOG2E * bf2f(gp[2]))); }
            if (tid == 0) UNI[0] = 0u;
            f32x16 ot0, ot1;
            { TileRegs t0, t1; tile_gload(t0, kc, vc, 64, 64, tid); tile_gload(t1, kc + 64 * 64, vc + 64 * 64, 64, 64, tid);
              tile_swrite(t0, K0, V0, tid); tile_swrite(t1, K0 + KT_BYTES, V0 + VT_BYTES, tid); }
            __syncthreads();
            {
                f32x16 sa, sb, sc, sd; tile_qk(K0, qf, sa, sb, lane); tile_qk(K0 + KT_BYTES, qf, sc, sd, lane);
                const int nmax = (tq - 31) >> 4;
                float mx = NEGF;
#pragma unroll
                for (int r = 0; r < 16; ++r) { const int nb = 8 * (r >> 2) + 4 * hi + (r & 3);
                    sa[r] = (nb <= nmax) ? sa[r] * SC_LOG2 : NEGF; sb[r] = (nb + 32 <= nmax) ? sb[r] * SC_LOG2 : NEGF;
                    sc[r] = (nb + 64 <= nmax) ? sc[r] * SC_LOG2 : NEGF; sd[r] = (nb + 96 <= nmax) ? sd[r] * SC_LOG2 : NEGF;
                    mx = fmaxf(fmaxf(mx, fmaxf(sa[r], sb[r])), fmaxf(sc[r], sd[r])); }
                mx = fmaxf(mx, __shfl_xor(mx, 32));
                const float mn = fmaxf(M_INIT, mx);
                float ls = 0.f;
#pragma unroll
                for (int r = 0; r < 16; ++r) { sa[r] = ex2(sa[r] - mn); sb[r] = ex2(sb[r] - mn); sc[r] = ex2(sc[r] - mn); sd[r] = ex2(sd[r] - mn); ls += (sa[r] + sb[r]) + (sc[r] + sd[r]); }
                const float lt = ls + __shfl_xor(ls, 32);
                const float inv = lt > 0.f ? 1.0f / lt : 0.f;
#pragma unroll
                for (int r = 0; r < 16; ++r) { sa[r] *= inv; sb[r] *= inv; sc[r] *= inv; sd[r] *= inv; }
                f32x16 oc0, oc1;
#pragma unroll
                for (int r = 0; r < 16; ++r) { oc0[r] = 0.f; oc1[r] = 0.f; }
                tile_pv(V0, sa, sb, oc0, oc1, lane); tile_pv(V0 + VT_BYTES, sc, sd, oc0, oc1, lane);
#pragma unroll
                for (int r = 0; r < 16; ++r) { ot0[r] = gt0 * oc0[r]; ot1[r] = gt0 * oc1[r]; }
                float core[16], last[16];
#pragma unroll
                for (int a = 0; a < 4; ++a) {
                    core[a] = (sa[4 * a] + sa[4 * a + 1]) + (sa[4 * a + 2] + sa[4 * a + 3]); last[a] = sa[4 * a + 3];
                    core[4 + a] = (sb[4 * a] + sb[4 * a + 1]) + (sb[4 * a + 2] + sb[4 * a + 3]); last[4 + a] = sb[4 * a + 3];
                    core[8 + a] = (sc[4 * a] + sc[4 * a + 1]) + (sc[4 * a + 2] + sc[4 * a + 3]); last[8 + a] = sc[4 * a + 3];
                    core[12 + a] = (sd[4 * a] + sd[4 * a + 1]) + (sd[4 * a + 2] + sd[4 * a + 3]); last[12 + a] = sd[4 * a + 3]; }
                float prev = 0.f;
                LAS float* ip = IMPH + (hl * 64 + tl) * 32 + hi;
#pragma unroll
                for (int mm = 0; mm < 16; ++mm) { const float rc = __shfl_xor(last[mm], 32);
                    ip[2 * mm] = core[mm] + (hi ? rc : prev); prev = rc; }
            }
            __syncthreads();
            { unsigned uw = 0u;
#pragma unroll
              for (int rnd = 0; rnd < 4; ++rnd) { const int tk = lane >> 5, j = lane & 31, t2 = 8 * wave + 2 * rnd + tk;
                  const float imp = ((IMPH[(0 * 64 + t2) * 32 + j] + IMPH[(1 * 64 + t2) * 32 + j]) + IMPH[(2 * 64 + t2) * 32 + j]) + IMPH[(3 * 64 + t2) * 32 + j];
                  const bool forced = (j == 0) || (j == c) || (j == c - 1);
                  const float val = j > c ? NEGF : (forced ? 1e30f : imp);
                  int rank = 0;
                  for (int i = 0; i < 32; ++i) { const float vi = __shfl(val, (lane & 32) + i); rank += (vi > val || (vi == val && i < j)) ? 1 : 0; }
                  const unsigned long long bal = __ballot(rank < 16);
                  const unsigned msk = tk ? (unsigned)(bal >> 32) : (unsigned)bal;
                  if (j == 0) SEL[t2] = msk;
                  uw |= (unsigned)bal | (unsigned)(bal >> 32); }
              if (lane == 0) atomicOr((unsigned*)UNI, uw); }
            __syncthreads();
            const unsigned mysel = SEL[tl];
            const unsigned uni = (unsigned)__builtin_amdgcn_readfirstlane((int)UNI[0]) & ((2u << c) - 1u);
            {
                float m = M_INIT, l = 0.f; f32x16 o0, o1;
#pragma unroll
                for (int r = 0; r < 16; ++r) { o0[r] = 0.f; o1[r] = 0.f; }
                const bf16* kbase = rowb + 1536 + g * 64; const bf16* vbase = rowb + 1792 + g * 64;
                unsigned rem = uni; int jc = __builtin_ctz(rem); rem &= rem - 1u; int buf = 0;
                TileRegs tr; tile_gload(tr, kbase + (size_t)(64 * jc) * B_INP, vbase + (size_t)(64 * jc) * B_INP, B_INP, B_INP, tid);
                tile_swrite(tr, K0, V0, tid);
                __syncthreads();
                for (;;) {
                    const int jn = rem ? __builtin_ctz(rem) : -1;
                    if (jn >= 0) { rem &= rem - 1u; tile_gload(tr, kbase + (size_t)(64 * jn) * B_INP, vbase + (size_t)(64 * jn) * B_INP, B_INP, B_INP, tid); }
                    { const bool lsel = ((mysel >> jc) & 1u) != 0u;
                      f32x16 p0, p1; tile_qk(K0 + buf * KT_BYTES, qf, p0, p1, lane);
                      const LAS float* rl = lutS + hl * LS + (lsel ? (DS - tq + 64 * jc + 4 * hi) : (DS + 64));
                      tile_softmax(p0, p1, rl, SC_LOG2, m, l, o0, o1);
                      tile_pv(V0 + buf * VT_BYTES, p0, p1, o0, o1, lane); }
                    if (jn >= 0) tile_swrite(tr, K0 + (buf ^ 1) * KT_BYTES, V0 + (buf ^ 1) * VT_BYTES, tid);
                    __syncthreads();
                    if (jn < 0) break;
                    jc = jn; buf ^= 1;
                }
                const float lt = l + __shfl_xor(l, 32);
                const float f = gt1 / lt;
#pragma unroll
                for (int r = 0; r < 16; ++r) { ot0[r] += f * o0[r]; ot1[r] += f * o1[r]; }
            }
            {
                float m = M_INIT, l = 0.f; f32x16 o0, o1;
#pragma unroll
                for (int r = 0; r < 16; ++r) { o0[r] = 0.f; o1[r] = 0.f; }
                const bf16* kbase = rowb + 2048 + g * 64; const bf16* vbase = rowb + 2304 + g * 64;
                const int kt0 = c >= 8 ? c - 8 : 0, n = c - kt0 + 1;
                TileRegs tr; tile_gload(tr, kbase + (size_t)(64 * kt0) * B_INP, vbase + (size_t)(64 * kt0) * B_INP, B_INP, B_INP, tid);
                tile_swrite(tr, K0, V0, tid);
                __syncthreads();
                for (int i = 0; i < n; ++i) {
                    const int buf = i & 1, kt = kt0 + i;
                    if (i + 1 < n) tile_gload(tr, kbase + (size_t)(64 * (kt + 1)) * B_INP, vbase + (size_t)(64 * (kt + 1)) * B_INP, B_INP, B_INP, tid);
                    { f32x16 p0, p1; tile_qk(K0 + buf * KT_BYTES, qf, p0, p1, lane);
                      const LAS float* rl = lutW + hl * LW + (DW - tq + 64 * kt + 4 * hi);
                      tile_softmax(p0, p1, rl, SC_LOG2, m, l, o0, o1);
                      tile_pv(V0 + buf * VT_BYTES, p0, p1, o0, o1, lane); }
                    if (i + 1 < n) tile_swrite(tr, K0 + (buf ^ 1) * KT_BYTES, V0 + (buf ^ 1) * VT_BYTES, tid);
                    __syncthreads();
                }
                const float lt = l + __shfl_xor(l, 32);
                const float f = gt2 / lt;
#pragma unroll
                for (int r = 0; r < 16; ++r) { ot0[r] += f * o0[r]; ot1[r] += f * o1[r]; }
            }
            store_o(O + tokq * D + h * 64, ot0, ot1, hi);
        }
    }
}
#if defined(NAIVE_ATTN)
__device__ __forceinline__ float dot64_lds(const float* qs, const bf16* kr) {
    float s = 0.f;
#pragma unroll
    for (int c = 0; c < 8; ++c) { const v4u w = *(const v4u*)(kr + 8 * c);
        s += qs[8 * c + 0] * bflo(w.x) + qs[8 * c + 1] * bfhi(w.x) + qs[8 * c + 2] * bflo(w.y) + qs[8 * c + 3] * bfhi(w.y) + qs[8 * c + 4] * bflo(w.z) + qs[8 * c + 5] * bfhi(w.z) + qs[8 * c + 6] * bflo(w.w) + qs[8 * c + 7] * bfhi(w.w); }
    return s;
}
__global__ void __launch_bounds__(256) naive_compress(const bf16* qkv, const float* pos, const float* w1, const float* w2, bf16* kcb, bf16* vcb) {
    const int id = blockIdx.x, kv = id & 1, g = (id >> 1) & 3, rest = id >> 3, n = rest % 127, b = rest / 127, tid = threadIdx.x;
    __shared__ float flat[2048]; __shared__ float h1[256];
    const int col0 = 1024 + kv * 256 + g * 64;
    for (int i = tid; i < 2048; i += 256) { const int l = i >> 6, d = i & 63; flat[i] = bf2f(qkv[(size_t)(b * S + 16 * n + l) * B_INP + col0 + d]) + pos[kv * 2048 + i]; }
    __syncthreads();
    float acc = 0.f;
    for (int k = 0; k < 2048; ++k) acc += flat[k] * w1[((size_t)kv * 2048 + k) * 256 + tid];
    { const float x = acc; const float t = tanhf(0.7978845608028654f * (x + 0.044715f * x * x * x)); h1[tid] = 0.5f * x * (1.f + t); }
    __syncthreads();
    bf16* dst = kv ? vcb : kcb;
    if (tid < 64) { float o = 0.f; for (int c = 0; c < 256; ++c) o += h1[c] * w2[((size_t)kv * 256 + c) * 64 + tid];
        dst[((size_t)(b * 4 + g) * 128 + n) * 64 + tid] = (bf16)f2bf(o);
        if (n == 126) dst[((size_t)(b * 4 + g) * 128 + 127) * 64 + tid] = 0; }
}
__global__ void __launch_bounds__(64) naive_attn_A(const bf16* qkv, const float* lutg, const float* sinks, bf16* o) {
    const int idx = blockIdx.x, h = idx & 15, tok = idx >> 4, b = tok >> 11, t = tok & 2047, g = h >> 3, lane = threadIdx.x;
    __shared__ float qs[64];
    qs[lane] = bf2f(qkv[(size_t)tok * A_IN + h * 64 + lane]); __syncthreads();
    float sc[2]; bool va[2];
_Pragma("unroll") for (int w = 0; w < 2; ++w) { const int dist = lane + 64 * w, s = t - dist; va[w] = s >= 0;
        sc[w] = va[w] ? dot64_lds(qs, qkv + (size_t)(b * S + s) * A_IN + 1024 + g * 64) * 0.125f + lutg[h * 2048 + dist] : NEGF; }
    const float sink = sinks[h];
    const float m = fmaxf(wave_max(fmaxf(sc[0], sc[1])), sink);
    float e[2]; e[0] = va[0] ? expf(sc[0] - m) : 0.f; e[1] = va[1] ? expf(sc[1] - m) : 0.f;
    const float den = fmaxf(wave_sum(e[0] + e[1]) + expf(sink - m), 1e-30f);
    float out = 0.f;
_Pragma("unroll") for (int w = 0; w < 2; ++w) for (int l = 0; l < 64; ++l) { const float pl = __shfl(e[w], l) / den; const int sl = t - l - 64 * w; if (sl >= 0) out += pl * bf2f(qkv[(size_t)(b * S + sl) * A_IN + 1152 + g * 64 + lane]); }
    o[(size_t)tok * D + h * 64 + lane] = (bf16)f2bf(out);
}
__global__ void __launch_bounds__(64) naive_kmean(const bf16* qkv, float* kmean) {
    const int id = blockIdx.x, h = id & 15, n = (id >> 4) & 7, b = id >> 7, lane = threadIdx.x;
    float s = 0.f; for (int i = 0; i < 256; ++i) s += bf2f(qkv[(size_t)(b * S + 256 * n + i) * C_IN + 1024 + h * 64 + lane]);
    kmean[(size_t)id * 64 + lane] = s * (1.f / 256.f);
}
__global__ void __launch_bounds__(64) naive_attn_C(const bf16* qkv, const float* lutg, const float* kmean, bf16* o) {
    const int idx = blockIdx.x, h = idx & 15, tok = idx >> 4, b = tok >> 11, t = tok & 2047, c = t >> 8, lane = threadIdx.x;
    __shared__ float qs[64]; __shared__ float sc[1024];
    qs[lane] = bf2f(qkv[(size_t)tok * C_IN + h * 64 + lane]); __syncthreads();
    float gate[8];
#pragma unroll
    for (int n = 0; n < 8; ++n) { float s = NEGF; if (n < c) { s = 0.f; const float* km = kmean + ((size_t)((b * 8 + n) * 16 + h)) * 64; for (int d = 0; d < 64; ++d) s += qs[d] * km[d]; } gate[n] = s; }
    int selb[3];
#pragma unroll
    for (int r = 0; r < 3; ++r) { int best = 0; float bv = gate[0];
#pragma unroll
        for (int n = 1; n < 8; ++n) if (gate[n] > bv) { bv = gate[n]; best = n; }
        selb[r] = best;
#pragma unroll
        for (int n = 0; n < 8; ++n) if (n == best) gate[n] = -3e38f; }
    float mx = NEGF;
    _Pragma("unroll") for (int sl = 0; sl < 4; ++sl) { const int blk = sl == 0 ? c : selb[sl - 1]; const bool bok = sl == 0 || blk < c;
        _Pragma("unroll") for (int w = 0; w < 4; ++w) { const int i = lane + 64 * w, s = 256 * blk + i, dist = t - s; const bool ok = bok && dist >= 0;
            float v = NEGF; if (ok) v = dot64_lds(qs, qkv + (size_t)(b * S + s) * C_IN + 1024 + h * 64) * 0.125f + lutg[h * 2048 + dist];
            sc[sl * 256 + i] = v; mx = fmaxf(mx, v); } }
    mx = wave_max(mx); __syncthreads();
    float den = 0.f;
    for (int k = lane; k < 1024; k += 64) { const float v = sc[k]; const float e = v > -1e29f ? expf(v - mx) : 0.f; sc[k] = e; den += e; }
    den = fmaxf(wave_sum(den), 1e-30f); __syncthreads();
    float out = 0.f;
    _Pragma("unroll") for (int sl = 0; sl < 4; ++sl) { const int blk = sl == 0 ? c : selb[sl - 1]; const bool bok = sl == 0 || blk < c; if (!bok) continue;
        for (int i = 0; i < 256; ++i) { const float p = sc[sl * 256 + i]; if (p != 0.f) out += p * bf2f(qkv[(size_t)(b * S + 256 * blk + i) * C_IN + 2048 + h * 64 + lane]); } }
    o[(size_t)tok * D + h * 64 + lane] = (bf16)f2bf(out / den);
}
__global__ void __launch_bounds__(64) naive_attn_B(const bf16* qkv, const float* lutg, const bf16* kcb, const bf16* vcb, bf16* o) {
    const int id = blockIdx.x, g = id & 3, tok = id >> 2, b = tok >> 11, t = tok & 2047, lane = threadIdx.x, cur = t >> 6;
    __shared__ float qs[4][64]; __shared__ float pc[4][128]; __shared__ float scs[4][1024]; __shared__ float scw[4][512];
    _Pragma("unroll") for (int r = 0; r < 4; ++r) qs[r][lane] = bf2f(qkv[(size_t)tok * B_INP + (4 * g + r) * 64 + lane]);
    __syncthreads();
    float otot[4] = {0.f, 0.f, 0.f, 0.f};
    float gt[4][3];
    _Pragma("unroll") for (int r = 0; r < 4; ++r) _Pragma("unroll") for (int i = 0; i < 3; ++i) { const float z = bf2f(qkv[(size_t)tok * B_INP + 2560 + (4 * g + r) * 3 + i]); gt[r][i] = 1.f / (1.f + expf(-z)); }
    const int nvalid = t >= 31 ? ((t - 31) >> 4) + 1 : 0;
    const bf16* kc = kcb + (size_t)(b * 4 + g) * 128 * 64; const bf16* vc = vcb + (size_t)(b * 4 + g) * 128 * 64;
    _Pragma("unroll") for (int r = 0; r < 4; ++r) { float s2[2]; bool va[2];
        _Pragma("unroll") for (int w = 0; w < 2; ++w) { const int n = lane + 64 * w; va[w] = n < nvalid; s2[w] = va[w] ? dot64_lds(qs[r], kc + (size_t)n * 64) * 0.125f : NEGF; }
        const float m = wave_max(fmaxf(s2[0], s2[1]));
        float e0 = va[0] ? expf(s2[0] - m) : 0.f, e1 = va[1] ? expf(s2[1] - m) : 0.f;
        const float den = fmaxf(wave_sum(e0 + e1), 1e-30f);
        pc[r][lane] = e0 / den; pc[r][lane + 64] = e1 / den; }
    __syncthreads();
    _Pragma("unroll") for (int r = 0; r < 4; ++r) { float a = 0.f; for (int n = 0; n < 127; ++n) a += pc[r][n] * bf2f(vc[(size_t)n * 64 + lane]); otot[r] += gt[r][0] * a; }
    float val = -3e38f;
    if (lane < 32) { const int j = lane; float imp = 0.f;
        _Pragma("unroll") for (int r = 0; r < 4; ++r) for (int n = 4 * j - 1; n <= 4 * j + 3; ++n) if (n >= 0 && n <= 126) imp += pc[r][n];
        const bool forced = (j == 0) || (j == cur) || (j == cur - 1);
        val = j > cur ? NEGF : (forced ? 1e30f : imp); }
    int rank = 0;
    for (int i = 0; i < 32; ++i) { const float vi = __shfl(val, i); rank += (vi > val || (vi == val && i < lane)) ? 1 : 0; }
    const unsigned long long bal = __ballot(lane < 32 && rank < 16);
    const unsigned selmask = (unsigned)bal;
    { int slot = 0; float mx[4] = {NEGF, NEGF, NEGF, NEGF};
      for (int jb = 0; jb < 32; ++jb) { if (!((selmask >> jb) & 1u)) continue;
          const int s = 64 * jb + lane, dist = t - s; const bool ok = dist >= 0;
          _Pragma("unroll") for (int r = 0; r < 4; ++r) { float v = NEGF; if (ok) v = dot64_lds(qs[r], qkv + (size_t)(b * S + s) * B_INP + 1536 + g * 64) * 0.125f + lutg[(4 * g + r) * 2048 + dist];
              scs[r][slot * 64 + lane] = v; mx[r] = fmaxf(mx[r], v); }
          ++slot; }
      __syncthreads();
      _Pragma("unroll") for (int r = 0; r < 4; ++r) { const float m = wave_max(mx[r]); float den = 0.f;
          for (int k = lane; k < 1024; k += 64) { const float v = scs[r][k]; const float e = v > -1e29f ? expf(v - m) : 0.f; scs[r][k] = e; den += e; }
          den = fmaxf(wave_sum(den), 1e-30f); __syncthreads();
          float a = 0.f; int sl2 = 0;
          for (int jb = 0; jb < 32; ++jb) { if (!((selmask >> jb) & 1u)) continue;
              for (int i = 0; i < 64; ++i) { const float p = scs[r][sl2 * 64 + i]; if (p != 0.f) a += p * bf2f(qkv[(size_t)(b * S + 64 * jb + i) * B_INP + 1792 + g * 64 + lane]); }
              ++sl2; }
          otot[r] += gt[r][1] * a / den; } }
    { float mx[4] = {NEGF, NEGF, NEGF, NEGF};
      _Pragma("unroll") for (int w = 0; w < 8; ++w) { const int dist = lane + 64 * w, s = t - dist; const bool ok = s >= 0;
          _Pragma("unroll") for (int r = 0; r < 4; ++r) { float v = NEGF; if (ok) v = dot64_lds(qs[r], qkv + (size_t)(b * S + s) * B_INP + 2048 + g * 64) * 0.125f + lutg[(4 * g + r) * 2048 + dist];
              scw[r][dist] = v; mx[r] = fmaxf(mx[r], v); } }
      __syncthreads();
      _Pragma("unroll") for (int r = 0; r < 4; ++r) { const float m = wave_max(mx[r]); float den = 0.f;
          for (int k = lane; k < 512; k += 64) { const float v = scw[r][k]; const float e = v > -1e29f ? expf(v - m) : 0.f; scw[r][k] = e; den += e; }
          den = fmaxf(wave_sum(den), 1e-30f); __syncthreads();
          float a = 0.f;
          for (int i = 0; i < 512; ++i) { const float p = scw[r][i]; if (p != 0.f) a += p * bf2f(qkv[(size_t)(b * S + t - i) * B_INP + 2304 + g * 64 + lane]); }
          otot[r] += gt[r][2] * a / den; } }
    _Pragma("unroll") for (int r = 0; r < 4; ++r) o[(size_t)tok * D + (4 * g + r) * 64 + lane] = (bf16)f2bf(otot[r]);
}
#endif
#ifndef PHASE_COMPRESS
#define PHASE_COMPRESS {}
#endif
#ifndef PHASE_ATTENTION
#define PHASE_ATTENTION {}
#endif

__device__ __forceinline__ void ph_gemm_swiglu(LAS unsigned char* lds, const bf16* A, const bf16* Bt, int N, int K, bf16* O, int ldc, int G) {
    pg8::Gemm g{A, Bt, M, N, K}; pg8::StaticOrder So; So.init(M, N, G, (int)blockIdx.x);
    pg8::EpiSwiglu E{O, ldc};
    pg8::gemm_phase<pg8::EpiSwiglu, pg8::StaticOrder, true, true>(lds, g, So, E);
}
__device__ __forceinline__ void ph_gemm_store(LAS unsigned char* lds, const bf16* A, const bf16* Bt, int N, int K, bf16* O, int ldc, int G) {
    pg8::Gemm g{A, Bt, M, N, K}; pg8::StaticOrder So; So.init(M, N, G, (int)blockIdx.x);
    pg8::EpiStore E{O, ldc};
    pg8::gemm_phase<pg8::EpiStore, pg8::StaticOrder, true, true>(lds, g, So, E);
}
__device__ __forceinline__ void ph_thin(const float* xin, float* xout, const bf16* y, bf16* hn, const float* gpost, const float* gpre, float c, int gw, int NGW, int lane) {
    thin_phase(xin, xout, y, hn, gpost, gpre, c, gw, NGW, lane);
}
struct Args { const float* in[15]; float* out; unsigned char* ws; int ph_lo, ph_hi; };
enum { IN_X = 0, IN_RELB, IN_NORMG, IN_FWI, IN_FWO, IN_AWI, IN_AWO, IN_ASINK, IN_BWI, IN_BWO, IN_BPOS, IN_BW1, IN_BW2, IN_CWI, IN_CWO };

__global__ void __launch_bounds__(NWAVES * 64, 2) mega_fwd(Args args) {
    extern __shared__ __attribute__((aligned(16))) unsigned char lds[];
    LAS unsigned char* const L = (LAS unsigned char*)lds;
    volatile LAS unsigned* MISC = (volatile LAS unsigned*)(L + MISC_OFF);
    const int tid = threadIdx.x, lane = tid & 63, wave = __builtin_amdgcn_readfirstlane(tid >> 6);
    const int G = gridDim.x;
    unsigned char* const ws = args.ws;
    gu32* const ctl = (gu32*)(ws + WS_CTL);
    for (int u = tid; u < (LDS_BYTES - LDSCTL_OFF) / 4; u += NWAVES * 64) ((LAS unsigned*)(L + LDSCTL_OFF))[u] = 0u;
    __syncthreads();
    XcdBarrier bar = xcd_barrier_post((unsigned*)(ctl + CW_BAR), MISC + 8);
    const int lo = args.ph_lo, hi = args.ph_hi;
    int pid = 0;
#define PH_BEGIN if (pid >= lo && pid < hi) {
#define PH_END if (pid + 1 < hi) xcd_barrier(bar); } ++pid;
    const int gw = wave * G + (int)blockIdx.x, NGW = G * NWAVES;
    bf16* const HN = (bf16*)(ws + WS_HN); bf16* const Y = (bf16*)(ws + WS_Y); bf16* const OB = (bf16*)(ws + WS_O); bf16* const BIG = (bf16*)(ws + WS_BIG);
    const float* const normg = args.in[IN_NORMG];

    PH_BEGIN
    {
#ifndef NO_PRO
        LAS float* scr = (LAS float*)(L + RING_OFF + wave * 16384);
        conv_w<1>(args.in[IN_FWI], 8, D, 2 * DFF, 2 * DFF, (bf16*)(ws + WS_WFI), scr, gw, NGW, lane);
        conv_w<0>(args.in[IN_FWO], 8, DFF, D, D, (bf16*)(ws + WS_WFO), scr, gw, NGW, lane);
        conv_w<0>(args.in[IN_AWI], 2, D, A_IN, A_IN, (bf16*)(ws + WS_WAI), scr, gw, NGW, lane);
        conv_w<0>(args.in[IN_AWO], 2, D, D, D, (bf16*)(ws + WS_WAO), scr, gw, NGW, lane);
        conv_w<0>(args.in[IN_BWI], 1, D, B_IN, B_INP, (bf16*)(ws + WS_WBI), scr, gw, NGW, lane);
        conv_w<0>(args.in[IN_BWO], 1, D, D, D, (bf16*)(ws + WS_WBO), scr, gw, NGW, lane);
        conv_w<0>(args.in[IN_BW1], 2, 2048, 256, 256, (bf16*)(ws + WS_WC1), scr, gw, NGW, lane);
        conv_w<0>(args.in[IN_BW2], 2, 256, 64, 64, (bf16*)(ws + WS_W2T), scr, gw, NGW, lane);
        conv_w<0>(args.in[IN_CWI], 1, D, C_IN, C_IN, (bf16*)(ws + WS_WCI), scr, gw, NGW, lane);
        conv_w<0>(args.in[IN_CWO], 1, D, D, D, (bf16*)(ws + WS_WCO), scr, gw, NGW, lane);
        for (int r = gw; r < B_INP - B_IN; r += NGW) { GAS v4u* p = (GAS v4u*)((bf16*)(ws + WS_WBI) + (size_t)(B_IN + r) * D);
            p[lane] = (v4u){0u, 0u, 0u, 0u}; p[lane + 64] = (v4u){0u, 0u, 0u, 0u}; }
        { float* lutg = (float*)(ws + WS_LUTG); const float* relb = args.in[IN_RELB];
          for (int i = (int)blockIdx.x * 512 + tid; i < 16 * 2048; i += G * 512) { const int h = i >> 11, d = i & 2047; lutg[i] = relb[rel_bucket(d) * 16 + h]; } }
        { float* b1 = (float*)(ws + WS_BIAS1); const float* pos = args.in[IN_BPOS]; const float* w1 = args.in[IN_BW1];
          for (int o = gw; o < 512; o += NGW) { const int kv = o >> 8, c = o & 255; float s = 0.f;
              for (int k = lane; k < 2048; k += 64) s += pos[kv * 2048 + k] * w1[((size_t)kv * 2048 + k) * 256 + c];
              s = wave_sum(s); if (lane == 0) b1[o] = s; } }
        for (int m = gw; m < M; m += NGW) norm_row(args.in[IN_X] + (size_t)m * D, normg, HN + (size_t)m * D, lane);
#endif
    }
    PH_END

    for (int s = 0; s < 12; ++s) {
        const int Lr = s / 3, j = s % 3, kind = Lr % 3, mj = Lr / 3;
        const float* g6 = normg + (size_t)Lr * 6 * D;
        if (j != 1) {
            const int half = j >> 1;
            PH_BEGIN
#ifndef NO_G1
            ph_gemm_swiglu(L + RING_OFF, HN, (const bf16*)(ws + WS_WFI) + (size_t)(Lr * 2 + half) * 2 * DFF * D, 2 * DFF, D, BIG, DFF, G);
#endif
            PH_END
        } else {
            PH_BEGIN
            { const int N = kind == 0 ? A_IN : (kind == 1 ? B_INP : C_IN);
              const bf16* Bt = kind == 0 ? (const bf16*)(ws + WS_WAI) + (size_t)mj * A_IN * D : (kind == 1 ? (const bf16*)(ws + WS_WBI) : (const bf16*)(ws + WS_WCI));
#ifndef NO_G2
              ph_gemm_store(L + RING_OFF, HN, Bt, N, D, BIG, N, G);
#endif
 }
            PH_END
            if (kind == 1) {
                PH_BEGIN
#if defined(FAST_CMP)
                compress_phase(L + RING_OFF, BIG, (const bf16*)(ws + WS_WC1), (const bf16*)(ws + WS_W2T), (const float*)(ws + WS_BIAS1), (bf16*)(ws + WS_KCB), (bf16*)(ws + WS_VCB), G);
#endif
                PH_END
            }
            PH_BEGIN
            { const float* lutg = (const float*)(ws + WS_LUTG);
              if (kind == 0) {
#if defined(FAST_A)
                  attn_phase_A(L + RING_OFF, BIG, lutg, args.in[IN_ASINK] + mj * 16, OB, G);
#endif
              } else if (kind == 1) {
#if defined(FAST_B)
                  attn_phase_B(L + RING_OFF, BIG, lutg, (const bf16*)(ws + WS_KCB), (const bf16*)(ws + WS_VCB), OB, G);
#endif
              } else {
#if defined(FAST_C)
                  attn_phase_C(L + RING_OFF, BIG, lutg, OB, G);
#endif
              } }
            PH_END
        }
        PH_BEGIN
        { const int K = (j != 1) ? DFF : D; const bf16* A = (j != 1) ? BIG : OB;
          const bf16* Bt = (j != 1) ? (const bf16*)(ws + WS_WFO) + (size_t)(Lr * 2 + (j >> 1)) * D * DFF
                                    : (kind == 0 ? (const bf16*)(ws + WS_WAO) + (size_t)mj * D * D : (kind == 1 ? (const bf16*)(ws + WS_WBO) : (const bf16*)(ws + WS_WCO)));
#ifndef NO_G3
          ph_gemm_store(L + RING_OFF, A, Bt, D, K, Y, D, G);
#endif
 }
        PH_END
        PH_BEGIN
        { const float* xin = (s == 0) ? args.in[IN_X] : args.out;
          const float* gpost = g6 + (size_t)(2 * j + 1) * D;
          const float* gpre = (s == 11) ? nullptr : (j == 2 ? g6 + (size_t)6 * D : g6 + (size_t)(2 * j + 2) * D);
#ifndef NO_THIN
          ph_thin(xin, args.out, Y, HN, gpost, gpre, j == 1 ? 1.0f : 0.5f, gw, NGW, lane);
#endif
 }
        PH_END
    }
#undef PH_BEGIN
#undef PH_END
}
#ifndef MK_MULTI
#define MK_MULTI 0
#endif
static void launch_range(Args a, int lo, int hi, int grid, hipStream_t stream) {
    a.ph_lo = lo; a.ph_hi = hi;
    hipLaunchKernelGGL(mega_fwd, dim3(grid), dim3(NWAVES * 64), LDS_BYTES, stream, a);
    const hipError_t le = hipPeekAtLastError();
    if (le != hipSuccess) fprintf(stderr, "kernel_launch: launch [%d,%d) failed: %s\n", lo, hi, hipGetErrorName(le));
}
extern "C" void kernel_launch(void* const* d_in, const int* in_sizes, int n_in, void* d_out, int out_size, void* d_ws, size_t ws_size, hipStream_t stream) {
    static int grid = 0;
    if (grid == 0) {
        if (n_in != 15 || in_sizes[0] != M * D || out_size != M * D || ws_size < WS_END) { fprintf(stderr, "kernel_launch: unexpected shapes (n_in %d, in0 %d, out %d, ws %zu)\n", n_in, n_in > 0 ? in_sizes[0] : -1, out_size, ws_size); grid = -1; return; }
        int dev = 0, cus = 0, per_cu = 0;
        if (hipGetDevice(&dev) != hipSuccess || hipDeviceGetAttribute(&cus, hipDeviceAttributeMultiprocessorCount, dev) != hipSuccess) { grid = -1; return; }
        if (hipFuncSetAttribute((const void*)mega_fwd, hipFuncAttributeMaxDynamicSharedMemorySize, LDS_BYTES) != hipSuccess) { fprintf(stderr, "kernel_launch: hipFuncSetAttribute failed\n"); grid = -1; return; }
        if (hipOccupancyMaxActiveBlocksPerMultiprocessor(&per_cu, (const void*)mega_fwd, NWAVES * 64, LDS_BYTES) != hipSuccess || per_cu < 1) { fprintf(stderr, "kernel_launch: occupancy query says %d\n", per_cu); per_cu = 1; }
        (void)hipGetLastError();
        grid = cus;
    }
    if (grid < 0) return;
    if (hipMemsetAsync((char*)d_ws + WS_CTL, 0, CTL_ZERO_BYTES, stream) != hipSuccess) return;
    Args a{};
    for (int i = 0; i < 15; ++i) a.in[i] = (const float*)d_in[i];
    a.out = (float*)d_out; a.ws = (unsigned char*)d_ws;
#if MK_MULTI
    unsigned char* ws = (unsigned char*)d_ws;
    int pid = 0;
    launch_range(a, pid, pid + 1, grid, stream); ++pid;
    for (int s = 0; s < 12; ++s) {
        const int Lr = s / 3, j = s % 3, kind = Lr % 3, mj = Lr / 3; (void)mj;
        if (j != 1) { launch_range(a, pid, pid + 1, grid, stream); ++pid; }
        else {
            launch_range(a, pid, pid + 1, grid, stream); ++pid;
            const bf16* qkv = (const bf16*)(ws + WS_BIG); const float* lutg = (const float*)(ws + WS_LUTG); bf16* ob = (bf16*)(ws + WS_O);
            if (kind == 1) {
#if !defined(FAST_CMP)
                hipLaunchKernelGGL(naive_compress, dim3(NB * 127 * 4 * 2), dim3(256), 0, stream, qkv, a.in[IN_BPOS], a.in[IN_BW1], a.in[IN_BW2], (bf16*)(ws + WS_KCB), (bf16*)(ws + WS_VCB));
#else
                launch_range(a, pid, pid + 1, grid, stream);
#endif
                ++pid;
            }
            bool fast = false;
#if defined(FAST_A)
            if (kind == 0) fast = true;
#endif
#if defined(FAST_B)
            if (kind == 1) fast = true;
#endif
#if defined(FAST_C)
            if (kind == 2) fast = true;
#endif
            if (fast) launch_range(a, pid, pid + 1, grid, stream);
#if defined(NAIVE_ATTN)
            else if (kind == 0) hipLaunchKernelGGL(naive_attn_A, dim3(M * 16), dim3(64), 0, stream, qkv, lutg, a.in[IN_ASINK] + mj * 16, ob);
            else if (kind == 1) hipLaunchKernelGGL(naive_attn_B, dim3(M * 4), dim3(64), 0, stream, qkv, lutg, (const bf16*)(ws + WS_KCB), (const bf16*)(ws + WS_VCB), ob);
            else { hipLaunchKernelGGL(naive_kmean, dim3(NB * 8 * 16), dim3(64), 0, stream, qkv, (float*)(ws + WS_KMEAN));
                   hipLaunchKernelGGL(naive_attn_C, dim3(M * 16), dim3(64), 0, stream, qkv, lutg, (const float*)(ws + WS_KMEAN), ob); }
#endif
            ++pid;
        }
        launch_range(a, pid, pid + 1, grid, stream); ++pid;
        launch_range(a, pid, pid + 1, grid, stream); ++pid;
    }
#else
    launch_range(a, 0, 1000, grid, stream);
#endif
}
```

```cpp
#define FAST_A 1
#define FAST_C 1
#define FAST_B 1
#define FAST_CMP 1
#include <hip/hip_runtime.h>
#include <cstdio>
#include <cstdint>
namespace pg8 {
#define PG8_LAS __attribute__((address_space(3)))
typedef unsigned short bf16_t;
typedef short bf16x8 __attribute__((ext_vector_type(8)));
typedef float f32x4 __attribute__((ext_vector_type(4)));
typedef unsigned u32x4 __attribute__((ext_vector_type(4)));
constexpr int BM = 256, BK = 64, HALF = 128, HTB = HALF * BK * 2  , STAGE_BYTES = 8 * HTB, NXCD = 8, WGM = 8;

__host__ __device__ __forceinline__ int lds_byte(int r, int c) { const int st = (r >> 4) * 2 + (c >> 5), rr = r & 15, cc = c & 31, ob = rr * 64 + cc * 2; return st * 1024 + (ob ^ (((ob >> 9) & 1) << 5)); }
__host__ __device__ __forceinline__ void stage_rc(int b, int& R, int& C) { const int st = b / 1024, sb = b % 1024, swz = sb ^ (((sb >> 9) & 1) << 5); R = (st >> 1) * 16 + swz / 64; C = (st & 1) * 32 + (swz % 64) / 2; }
__host__ __device__ __forceinline__ int perm32(int rho) { const int n = rho >> 4, i = rho & 15; return 8 * (i >> 2) + 4 * n + (i & 3); }

struct Unit { int pm, pn; };
struct Gemm { const bf16_t* A; const bf16_t* Bt; int M, N, K; };

struct StaticOrder {
    int nM, nN, nwg, G, c;
    __host__ __device__ void init(int M, int N, int G_, int c_) { nM = M / BM; nN = N / BM; nwg = nM * nN; G = G_; c = c_; }
    __host__ __device__ bool next(int i, Unit& u) const {
        const long L = (long)i * G + c; if (L >= nwg) return false;
        int wgid = (int)L; { const int q = nwg / NXCD, r = nwg % NXCD, xcd = wgid % NXCD, off = wgid / NXCD; wgid = (xcd < r ? xcd * (q + 1) : r * (q + 1) + (xcd - r) * q) + off; }
        const int nig = WGM * nN, gid = wgid / nig, fm = gid * WGM, gsz = (nM - fm) < WGM ? (nM - fm) : WGM;
        u.pm = fm + ((wgid % nig) % gsz); u.pn = (wgid % nig) / gsz; return true;
    }
    __device__ __forceinline__ void a_ready(const Unit&) const {}
    __device__ __forceinline__ void done(const Unit&) const {}
};

__device__ __forceinline__ unsigned cvt_pk_bf16(float lo, float hi) { unsigned r; asm volatile("v_cvt_pk_bf16_f32 %0, %1, %2" : "=v"(r) : "v"(lo), "v"(hi)); return r; }
constexpr float RS_EPS = 1e-6f, RS_INVD = 1.0f / 1024.0f;
template <bool SCALE> struct EpiStore {
    static constexpr bool PERM = true, AFTER_DRAIN = false;
    bf16_t* O; int ldc; const float* ssq;
    __device__ __forceinline__ void operator()(const f32x4 (&acc)[2][2][4][2], const Unit& u, int wr, int wc, int fr, int fq) const {
        const int row0 = u.pm * BM + wr * 64 + fr; const int col0 = u.pn * BM + wc * 32 + 8 * fq;
#pragma unroll
        for (int ai = 0; ai < 2; ++ai)
#pragma unroll
            for (int m = 0; m < 4; ++m) { bf16_t* rowp = O + (size_t)(row0 + ai * HALF + m * 16) * ldc + col0;
                float rs = 1.0f; if (SCALE) rs = __builtin_amdgcn_rsqf(ssq[row0 + ai * HALF + m * 16] * RS_INVD + RS_EPS);
#pragma unroll
                for (int bj = 0; bj < 2; ++bj) { const f32x4 v0 = acc[ai][bj][m][0] * rs, v1 = acc[ai][bj][m][1] * rs;
                    u32x4 w; w.x = cvt_pk_bf16(v0[0], v0[1]); w.y = cvt_pk_bf16(v0[2], v0[3]); w.z = cvt_pk_bf16(v1[0], v1[1]); w.w = cvt_pk_bf16(v1[2], v1[3]);
                    *(u32x4*)(rowp + bj * HALF) = w; } }
    }
};
__device__ __forceinline__ float silu_mul(float g, float u) { return g * __builtin_amdgcn_rcpf(1.0f + __builtin_amdgcn_exp2f(-1.4426950408889634f * g)) * u; }
struct EpiSwiglu {
    static constexpr bool PERM = true, AFTER_DRAIN = false;
    bf16_t* O; int ldc; const float* ssq;
    __device__ __forceinline__ void operator()(const f32x4 (&acc)[2][2][4][2], const Unit& u, int wr, int wc, int fr, int fq) const {
        const int row0 = u.pm * BM + wr * 64 + fr; const int col0 = u.pn * HALF + wc * 32 + 8 * fq;
#pragma unroll
        for (int ai = 0; ai < 2; ++ai)
#pragma unroll
            for (int m = 0; m < 4; ++m) { bf16_t* rowp = O + (size_t)(row0 + ai * HALF + m * 16) * ldc + col0;
                const float rs = __builtin_amdgcn_rsqf(ssq[row0 + ai * HALF + m * 16] * RS_INVD + RS_EPS);
                const f32x4 g0 = acc[ai][0][m][0] * rs, g1 = acc[ai][0][m][1] * rs, u0 = acc[ai][1][m][0] * rs, u1 = acc[ai][1][m][1] * rs;
                u32x4 w; w.x = cvt_pk_bf16(silu_mul(g0[0], u0[0]), silu_mul(g0[1], u0[1])); w.y = cvt_pk_bf16(silu_mul(g0[2], u0[2]), silu_mul(g0[3], u0[3]));
                w.z = cvt_pk_bf16(silu_mul(g1[0], u1[0]), silu_mul(g1[1], u1[1])); w.w = cvt_pk_bf16(silu_mul(g1[2], u1[2]), silu_mul(g1[3], u1[3]));
                *(u32x4*)rowp = w; }
    }
};
template <class Epi, class Sched, bool ALIGN_EPI = false, bool SP2 = false>
__device__ __forceinline__ void gemm_phase(PG8_LAS unsigned char* lds, const Gemm g, const Sched& S, const Epi& E) {
    int tid_ = threadIdx.x; asm volatile("" : "+v"(tid_));
    const int tid = tid_, wid = __builtin_amdgcn_readfirstlane(tid >> 6), lane = tid & 63, wr = wid >> 2, wc = wid & 3, fr = lane & 15, fq = lane >> 4;
    const int K = g.K, nt = K / BK;
    unsigned voffA[2], voffB[2];
#pragma unroll
    for (int i = 0; i < 2; ++i) { int R, C; stage_rc(tid * 16 + i * 8192, R, C); const int Rb = Epi::PERM ? ((R & ~31) + perm32(R & 31)) : R;
        voffA[i] = (unsigned)(R * K + C) * 2u; voffB[i] = (unsigned)(Rb * K + C) * 2u; }
    const size_t kstep = (size_t)(BK * 2);
    const size_t hstep = (size_t)HALF * K * 2;
    const size_t tstep = 2 * hstep;
    const unsigned ldsw = (unsigned)wid * 1024u;
    const int aoff = lds_byte(wr * 64 + fr, fq * 8), boff = lds_byte(wc * 32 + fr, fq * 8);
#define PG8_SA(b, h) (((b) * 2 + (h)) * HTB)
#define PG8_SB(b, h) ((4 + (b) * 2 + (h)) * HTB)
#define PG8_STAGE(bufoff, gbase, voff) do { _Pragma("unroll") for (int _i = 0; _i < 2; ++_i) \
        __builtin_amdgcn_global_load_lds((const unsigned*)((const char*)(gbase) + (voff)[_i]), (PG8_LAS unsigned*)(lds + (bufoff) + ldsw + _i * 8192), 16, 0, 0); } while (0)
#define PG8_LDA(dst, b, h) do { _Pragma("unroll") for (int m = 0; m < 4; ++m) _Pragma("unroll") for (int k = 0; k < 2; ++k) dst[m][k] = *(const PG8_LAS bf16x8*)(lds + PG8_SA(b, h) + aoff + m * 2048 + k * 1024); } while (0)
#define PG8_LDB(dst, b, h) do { _Pragma("unroll") for (int n = 0; n < 2; ++n) _Pragma("unroll") for (int k = 0; k < 2; ++k) dst[n][k] = *(const PG8_LAS bf16x8*)(lds + PG8_SB(b, h) + boff + n * 2048 + k * 1024); } while (0)
#define PG8_MMA(ai, bj, At, Bt) do { __builtin_amdgcn_s_setprio(1); _Pragma("unroll") for (int m = 0; m < 4; ++m) _Pragma("unroll") for (int n = 0; n < 2; ++n) _Pragma("unroll") for (int k = 0; k < 2; ++k) \
        acc[ai][bj][m][n] = __builtin_amdgcn_mfma_f32_16x16x32_bf16(Bt[n][k], At[m][k], acc[ai][bj][m][n], 0, 0, 0); __builtin_amdgcn_s_setprio(0); } while (0)
#define PG8_WAIT_V(n) asm volatile("s_waitcnt vmcnt(" #n ")" ::: "memory")
#define PG8_WAIT_L(n) asm volatile("s_waitcnt lgkmcnt(" #n ")" ::: "memory")
#define PG8_BAR __builtin_amdgcn_s_barrier()
#define PG8_SCHED __builtin_amdgcn_sched_barrier(0)
    Unit cur, nxt; int ui = 0;
    if (!S.next(0, cur)) return;
    f32x4 acc[2][2][4][2];
#pragma unroll
    for (int a = 0; a < 2; ++a)
#pragma unroll
        for (int b = 0; b < 2; ++b)
#pragma unroll
            for (int m = 0; m < 4; ++m)
#pragma unroll
                for (int n = 0; n < 2; ++n) acc[a][b][m][n] = (f32x4){0.f, 0.f, 0.f, 0.f};
    bf16x8 At[4][2], B0[2][2], B1[2][2];
    const char* cA = (const char*)g.A + (size_t)cur.pm * tstep; const char* cB = (const char*)g.Bt + (size_t)cur.pn * tstep;
    S.a_ready(cur);
    if constexpr (SP2) {
        PG8_STAGE(PG8_SB(0, 0), cB, voffB); PG8_STAGE(PG8_SB(0, 1), cB + hstep, voffB); PG8_STAGE(PG8_SA(0, 0), cA, voffA); PG8_STAGE(PG8_SA(0, 1), cA + hstep, voffA);
        if (wr == 1) PG8_BAR;
        PG8_WAIT_V(2); PG8_BAR;
        PG8_STAGE(PG8_SB(1, 0), cB + kstep, voffB); PG8_STAGE(PG8_SA(1, 0), cA + kstep, voffA); PG8_STAGE(PG8_SB(1, 1), cB + hstep + kstep, voffB);
        PG8_WAIT_V(6); PG8_BAR;
    } else {
        PG8_STAGE(PG8_SB(0, 0), cB, voffB); PG8_STAGE(PG8_SA(0, 0), cA, voffA); PG8_STAGE(PG8_SB(0, 1), cB + hstep, voffB); PG8_STAGE(PG8_SA(0, 1), cA + hstep, voffA);
        if (wr == 1) PG8_BAR;
        PG8_WAIT_V(4); PG8_BAR;
        PG8_STAGE(PG8_SB(1, 0), cB + kstep, voffB); PG8_STAGE(PG8_SA(1, 0), cA + kstep, voffA); PG8_STAGE(PG8_SB(1, 1), cB + hstep + kstep, voffB);
        PG8_WAIT_V(6); PG8_BAR;
    }
    for (;;) {
        const bool has_next = S.next(ui + 1, nxt);
        const char* nA = has_next ? (const char*)g.A + (size_t)nxt.pm * tstep : cA; const char* nB = has_next ? (const char*)g.Bt + (size_t)nxt.pn * tstep : cB;
        for (int t = 0; t < nt; t += 2) {
            const bool last = (t == nt - 2);
            const char* a1 = cA + (size_t)(t + 1) * kstep;
            const char* a2 = last ? nA : cA + (size_t)(t + 2) * kstep; const char* b2 = last ? nB : cB + (size_t)(t + 2) * kstep;
            const char* a3 = a2 + kstep; const char* b3 = b2 + kstep;
            if (last && has_next) S.a_ready(nxt);
            if constexpr (SP2) {
            PG8_LDB(B0, 0, 0); PG8_LDB(B1, 0, 1); PG8_SCHED; PG8_LDA(At, 0, 0); PG8_STAGE(PG8_SA(1, 1), a1 + hstep, voffA);
            PG8_WAIT_V(8); PG8_WAIT_L(0); PG8_BAR; PG8_MMA(0, 0, At, B0); PG8_MMA(0, 1, At, B1); PG8_BAR; PG8_SCHED;
            PG8_LDA(At, 0, 1); PG8_STAGE(PG8_SB(0, 0), b2, voffB); PG8_STAGE(PG8_SB(0, 1), b2 + hstep, voffB); PG8_STAGE(PG8_SA(0, 0), a2, voffA);
            PG8_WAIT_V(8); PG8_WAIT_L(0); PG8_BAR; PG8_MMA(1, 0, At, B0); PG8_MMA(1, 1, At, B1); PG8_BAR; PG8_SCHED;
            PG8_LDB(B0, 1, 0); PG8_LDB(B1, 1, 1); PG8_SCHED; PG8_LDA(At, 1, 0); PG8_STAGE(PG8_SA(0, 1), a2 + hstep, voffA);
            PG8_WAIT_V(8); PG8_WAIT_L(0); PG8_BAR; PG8_MMA(0, 0, At, B0); PG8_MMA(0, 1, At, B1); PG8_BAR; PG8_SCHED;
            PG8_LDA(At, 1, 1); PG8_STAGE(PG8_SB(1, 0), b3, voffB); PG8_STAGE(PG8_SB(1, 1), b3 + hstep, voffB); PG8_STAGE(PG8_SA(1, 0), a3, voffA);
            PG8_WAIT_V(8); PG8_WAIT_L(0); PG8_BAR; PG8_MMA(1, 0, At, B0); PG8_MMA(1, 1, At, B1); PG8_BAR; PG8_SCHED;
            } else {
            PG8_LDB(B0, 0, 0); PG8_SCHED; PG8_LDA(At, 0, 0); PG8_STAGE(PG8_SA(1, 1), a1 + hstep, voffA);
            PG8_WAIT_L(8); PG8_BAR; PG8_WAIT_L(0); PG8_MMA(0, 0, At, B0); PG8_BAR; PG8_SCHED;
            PG8_LDB(B1, 0, 1); PG8_STAGE(PG8_SB(0, 0), b2, voffB);
            PG8_BAR; PG8_WAIT_L(0); PG8_MMA(0, 1, At, B1); PG8_BAR;
            PG8_LDA(At, 0, 1); PG8_STAGE(PG8_SA(0, 0), a2, voffA);
            PG8_BAR; PG8_WAIT_L(0); PG8_MMA(1, 0, At, B0); PG8_BAR; PG8_SCHED;
            PG8_STAGE(PG8_SB(0, 1), b2 + hstep, voffB);
            PG8_WAIT_V(6); PG8_BAR; PG8_MMA(1, 1, At, B1); PG8_BAR;
            PG8_LDB(B0, 1, 0); PG8_SCHED; PG8_LDA(At, 1, 0); PG8_STAGE(PG8_SA(0, 1), a2 + hstep, voffA);
            PG8_WAIT_L(8); PG8_BAR; PG8_WAIT_L(0); PG8_MMA(0, 0, At, B0); PG8_BAR; PG8_SCHED;
            PG8_LDB(B1, 1, 1); PG8_STAGE(PG8_SB(1, 0), b3, voffB);
            PG8_BAR; PG8_WAIT_L(0); PG8_MMA(0, 1, At, B1); PG8_BAR;
            PG8_LDA(At, 1, 1); PG8_STAGE(PG8_SA(1, 0), a3, voffA);
            PG8_BAR; PG8_WAIT_L(0); PG8_MMA(1, 0, At, B0); PG8_BAR; PG8_SCHED;
            PG8_STAGE(PG8_SB(1, 1), b3 + hstep, voffB);
            PG8_WAIT_V(6); PG8_BAR; PG8_MMA(1, 1, At, B1); PG8_BAR;
            }
        }
        if constexpr (ALIGN_EPI) { if (wr == 0) PG8_BAR; }
        if constexpr (!Epi::AFTER_DRAIN) { E(acc, cur, wr, wc, fr, fq); S.done(cur); }
        if (!has_next) break;
#pragma unroll
        for (int a = 0; a < 2; ++a)
#pragma unroll
            for (int b = 0; b < 2; ++b)
#pragma unroll
                for (int m = 0; m < 4; ++m)
#pragma unroll
                    for (int n = 0; n < 2; ++n) acc[a][b][m][n] = (f32x4){0.f, 0.f, 0.f, 0.f};
        cur = nxt; cA = nA; cB = nB; ++ui;
        if constexpr (ALIGN_EPI) { if (wr == 1) PG8_BAR; }
    }
    PG8_WAIT_V(0);
    if constexpr (!ALIGN_EPI) { if (wr == 0) PG8_BAR; }
    PG8_BAR;
    if constexpr (Epi::AFTER_DRAIN) { E.fused(acc, cur, wr, wc, fr, fq, lds, wid, lane); S.done(cur); }
#undef PG8_SA
#undef PG8_SB
#undef PG8_STAGE
#undef PG8_LDA
#undef PG8_LDB
#undef PG8_MMA
#undef PG8_WAIT_V
#undef PG8_WAIT_L
#undef PG8_BAR
#undef PG8_SCHED
}
}
#define GAS __attribute__((address_space(1)))
#define LAS __attribute__((address_space(3)))
typedef unsigned short bf16;
typedef unsigned v4u __attribute__((ext_vector_type(4)));
typedef float f32x4 __attribute__((ext_vector_type(4)));
typedef short bf16x8 __attribute__((ext_vector_type(8)));
typedef GAS unsigned gu32;
typedef GAS unsigned long long gu64;
#define RLX_AGENT __ATOMIC_RELAXED, __HIP_MEMORY_SCOPE_AGENT
#define LDS_WAIT() asm volatile("s_waitcnt lgkmcnt(0)" ::: "memory")
#define VM_WAIT() asm volatile("s_waitcnt vmcnt(0)" ::: "memory")
__device__ __forceinline__ unsigned long long rt() { return __builtin_amdgcn_s_memrealtime(); }
__device__ __forceinline__ unsigned f2bf(float f) { unsigned u = __builtin_bit_cast(unsigned, f); return (u + 0x7fffu + ((u >> 16) & 1u)) >> 16; }
__device__ __forceinline__ unsigned pk2(float lo, float hi) { return f2bf(lo) | (f2bf(hi) << 16); }

#define XB_TMO      128
#define XB_XCNT(j)  (256  + 64 * (j))
#define XB_XSUB(j)  (1280 + 64 * (j))
#define XB_XGEN(j)  (2304 + 64 * (j))
#define XB_TOP      3328
#define XB_TOPGEN   3392
#define XCD_BAR_WORDS 3456
#define XB_SPIN_CAP (1u << 18)

__device__ __forceinline__ unsigned xb_ld(unsigned* p)              { return __hip_atomic_load(p, __ATOMIC_RELAXED, __HIP_MEMORY_SCOPE_AGENT); }
__device__ __forceinline__ unsigned xb_add(unsigned* p, unsigned v) { return __hip_atomic_fetch_add(p, v, __ATOMIC_RELAXED, __HIP_MEMORY_SCOPE_AGENT); }
__device__ __forceinline__ unsigned xb_xcc_id() { return (unsigned)__builtin_amdgcn_s_getreg((3 << 11) | 20) & 0xFu; }
#define XB_SPIN(cond, bar) do { unsigned _sp = 0; while (cond) { __builtin_amdgcn_s_sleep(1); \
    if ((++_sp & 255u) == 0u) { if (xb_ld(&(bar)[XB_TMO])) break; if (_sp > XB_SPIN_CAP) { atomicAdd(&(bar)[XB_TMO], 1u); break; } } } } while (0)

struct XcdBarrier {
    unsigned* bar; unsigned x;
    volatile LAS unsigned* st;
};

__device__ __forceinline__ XcdBarrier xcd_barrier_post(unsigned* bar, volatile LAS unsigned* st) {
    XcdBarrier b; b.bar = bar; b.x = xb_xcc_id(); b.st = st;
    if (threadIdx.x == 0) (void)xb_add(&bar[XB_XCNT(b.x)], 1u);
    return b;
}
__device__ __forceinline__ void xcd_barrier_complete(unsigned* bar, unsigned x, unsigned& nloc, unsigned& nx) {
    const unsigned G = gridDim.x * gridDim.y * gridDim.z;
    unsigned sum, cnt, mine, sp = 0u;
    for (;;) {
        sum = 0u; cnt = 0u; mine = 0u;
#pragma unroll
        for (unsigned j = 0; j < 16; ++j) { const unsigned c = xb_ld(&bar[XB_XCNT(j)]); sum += c; cnt += (c > 0u) ? 1u : 0u; mine = (j == x) ? c : mine; }
        if (sum == G) break;
        __builtin_amdgcn_s_sleep(1);
        if ((++sp & 255u) == 0u) { if (xb_ld(&bar[XB_TMO])) break; if (sp > XB_SPIN_CAP) { atomicAdd(&bar[XB_TMO], 1u); break; } }
    }
    nloc = mine > 0u ? mine : 1u; nx = cnt > 0u ? cnt : 1u;
}

__device__ __forceinline__ void xcd_barrier(const XcdBarrier& b) {
    asm volatile("s_waitcnt vmcnt(0)" ::: "memory");
    __syncthreads();
    if (threadIdx.x == 0) {
        unsigned* bar = b.bar;
        __builtin_amdgcn_s_waitcnt(0);
        unsigned nloc = b.st[0], nx = b.st[1];
        if (nloc == 0u) { xcd_barrier_complete(bar, b.x, nloc, nx); b.st[0] = nloc; b.st[1] = nx; }
        const unsigned old = xb_add(&bar[XB_XSUB(b.x)], 1u);
        const unsigned gen = old / nloc;
        if (old + 1u == (gen + 1u) * nloc) {
            __builtin_amdgcn_fence(__ATOMIC_RELEASE, "agent");
            asm volatile("s_waitcnt vmcnt(0)" ::: "memory");
            const unsigned og = xb_add(&bar[XB_TOP], 1u);
            const unsigned tg = og / nx;
            if (og + 1u == (tg + 1u) * nx) xb_add(&bar[XB_TOPGEN], 1u);
            else XB_SPIN(xb_ld(&bar[XB_TOPGEN]) == tg, bar);
            __builtin_amdgcn_fence(__ATOMIC_ACQUIRE, "agent");
            xb_add(&bar[XB_XGEN(b.x)], 1u);
            asm volatile("s_waitcnt vmcnt(0)" ::: "memory");
        } else {
            XB_SPIN(xb_ld(&bar[XB_XGEN(b.x)]) == gen, bar);
            __builtin_amdgcn_fence(__ATOMIC_ACQUIRE, "agent");
            asm volatile("s_waitcnt vmcnt(0)" ::: "memory");
        }
    }
    __syncthreads();
}
constexpr int NB = 16, S = 2048, D = 1024, M = NB * S, DEPTH = 4, H = 16, HD = 64, DFF = 2816;
constexpr int A_IN = 1280, B_IN = 2608, B_INP = 2816, C_IN = 3072;
constexpr float NORM_EPS = 1e-6f;
constexpr float NEGF = -1e30f;
constexpr float LOG2E = 1.4426950408889634f;
constexpr int NWAVES = 8;

constexpr size_t MiB = 1u << 20;
constexpr size_t WS_CTL = 0, CTL_ZERO_BYTES = 1 * MiB;
constexpr size_t WS_LUTG = 1 * MiB;
constexpr size_t WS_BIAS1 = WS_LUTG + 131072;
constexpr size_t WS_W2T = WS_BIAS1 + 32768;
constexpr size_t WS_SSQ = WS_W2T + 65536;
constexpr size_t WS_KCB = 2 * MiB, WS_VCB = 3 * MiB;
constexpr size_t WS_WFI = 4 * MiB;
constexpr size_t WS_WFO = 92 * MiB;
constexpr size_t WS_WAI = 136 * MiB;
constexpr size_t WS_WAO = 141 * MiB;
constexpr size_t WS_WBI = 145 * MiB;
constexpr size_t WS_WBO = 151 * MiB;
constexpr size_t WS_WC1 = 153 * MiB;
constexpr size_t WS_WCI = 155 * MiB;
constexpr size_t WS_WCO = 161 * MiB;
constexpr size_t WS_HN = 164 * MiB, WS_Y = 228 * MiB, WS_O = 292 * MiB, WS_BIG = 356 * MiB, WS_KMEAN = 548 * MiB, WS_END = 552 * MiB;
constexpr int CW_BAR = 4096;

constexpr int RING_OFF = 0, RING_BYTES = 131072;
constexpr int LDSCTL_OFF = RING_BYTES, MISC_OFF = LDSCTL_OFF + 320;
constexpr int LDS_BYTES = 147456;

__device__ __forceinline__ float bf2f(bf16 v) { return __uint_as_float(((unsigned)v) << 16); }
__device__ __forceinline__ float bflo(unsigned w) { return __uint_as_float(w << 16); }
__device__ __forceinline__ float bfhi(unsigned w) { return __uint_as_float(w & 0xffff0000u); }
__device__ __forceinline__ float wave_sum(float v) {
#pragma unroll
    for (int o = 1; o < 64; o <<= 1) v += __shfl_xor(v, o);
    return v;
}
__device__ __forceinline__ float wave_max(float v) {
#pragma unroll
    for (int o = 1; o < 64; o <<= 1) v = fmaxf(v, __shfl_xor(v, o));
    return v;
}
__host__ __device__ __forceinline__ int rel_bucket(int d) {
    if (d < 16) return d < 0 ? 0 : d;
    return 16 + (d >= 21) + (d >= 27) + (d >= 35) + (d >= 46) + (d >= 59) + (d >= 77) + (d >= 99) + (d >= 128) + (d >= 166) + (d >= 216) + (d >= 280) + (d >= 363) + (d >= 470) + (d >= 609) + (d >= 790);
}

template <int MODE> __device__ __forceinline__ void conv_w(const float* W, int nmat, int K, int N, int NP, bf16* dst, LAS float* scr, int gw, int NGW, int lane, const float* gbase = nullptr, int gs_hi = 0, int gs_lo = 0) {
    const int nblk = (N + 31) / 32, kblk = K / 64, per = nblk * kblk, total = nmat * per;
    const int kk = lane >> 3, c4 = lane & 7;
    for (int it = gw; it < total; it += NGW) {
        const int mat = it / per, r = it % per, kb = r / nblk, nb = r % nblk, k0 = 64 * kb, n0 = 32 * nb;
        const float* Wm = W + (size_t)mat * K * N; bf16* Dm = dst + (size_t)mat * NP * K;
        const bool ok = n0 + 4 * c4 < N;
        f32x4 v[8];
#pragma unroll
        for (int i = 0; i < 8; ++i) v[i] = ok ? *(const GAS f32x4*)(Wm + (size_t)(k0 + 8 * i + kk) * N + n0 + 4 * c4) : (f32x4){0.f, 0.f, 0.f, 0.f};
        if (gbase) { const float gl = gbase[(size_t)(mat >> 1) * gs_hi + (size_t)(mat & 1) * gs_lo + k0 + lane];
#pragma unroll
            for (int i = 0; i < 8; ++i) { const float gk = __shfl(gl, 8 * i + kk); v[i] = v[i] * gk; } }
#pragma unroll
        for (int i = 0; i < 8; ++i) { LAS float* d = scr + (8 * i + kk) * 33 + 4 * c4; d[0] = v[i].x; d[1] = v[i].y; d[2] = v[i].z; d[3] = v[i].w; }
        LDS_WAIT(); asm volatile("" ::: "memory");
        const int c = lane & 7;
#pragma unroll
        for (int j = 0; j < 4; ++j) { const int n = (lane >> 3) + 8 * j; const int nn = n0 + n; const LAS float* sp = scr + (8 * c) * 33 + n;
            v4u o; o.x = pk2(sp[0 * 33], sp[1 * 33]); o.y = pk2(sp[2 * 33], sp[3 * 33]); o.z = pk2(sp[4 * 33], sp[5 * 33]); o.w = pk2(sp[6 * 33], sp[7 * 33]);
            int row = nn;
            if (MODE == 1) { const int hf = nn >= DFF ? 1 : 0, jj = nn - hf * DFF; row = 256 * (jj >> 7) + 128 * hf + (jj & 127); }
            if (nn < N) *(GAS v4u*)(Dm + (size_t)row * K + k0 + 8 * c) = o; }
        LDS_WAIT(); asm volatile("" ::: "memory");
    }
}
__device__ __forceinline__ void prep_row(const float* xrow, bf16* orow, float* ssq, int lane) {
    f32x4 v[4]; float s = 0.f;
#pragma unroll
    for (int j = 0; j < 4; ++j) { v[j] = *(const GAS f32x4*)(xrow + 256 * j + 4 * lane); s += (v[j].x * v[j].x + v[j].y * v[j].y) + (v[j].z * v[j].z + v[j].w * v[j].w); }
    s = wave_sum(s); if (lane == 0) *ssq = s;
#pragma unroll
    for (int j = 0; j < 4; ++j) { const unsigned lo = pk2(v[j].x, v[j].y), hi = pk2(v[j].z, v[j].w);
        *(GAS unsigned long long*)(orow + 256 * j + 4 * lane) = (unsigned long long)lo | ((unsigned long long)hi << 32); }
}
__device__ __forceinline__ void unpack8(float* d, const v4u w) { d[0] = bflo(w.x); d[1] = bfhi(w.x); d[2] = bflo(w.y); d[3] = bfhi(w.y); d[4] = bflo(w.z); d[5] = bfhi(w.z); d[6] = bflo(w.w); d[7] = bfhi(w.w); }
__device__ __forceinline__ void thin_phase(const float* xin32, const bf16* xb, bf16* xbo, float* ssq, const bf16* y, const float* gpost, float c, float* out32, int gw, int NGW, int lane) {
    asm volatile("" : "+v"(lane));
    float gp[16];
#pragma unroll
    for (int j = 0; j < 2; ++j)
#pragma unroll
        for (int e = 0; e < 8; ++e) gp[j * 8 + e] = gpost[j * 512 + lane * 8 + e] * c;
    constexpr int RB = 4;
    for (int m0 = gw * RB; m0 < M; m0 += NGW * RB) {
        v4u yw[RB][2]; float xv[RB][16];
#pragma unroll
        for (int r = 0; r < RB; ++r)
#pragma unroll
            for (int j = 0; j < 2; ++j) yw[r][j] = *(const GAS v4u*)(y + (size_t)(m0 + r) * D + j * 512 + lane * 8);
        if (xin32) {
#pragma unroll
            for (int r = 0; r < RB; ++r)
#pragma unroll
                for (int j = 0; j < 2; ++j) { const float* xr = xin32 + (size_t)(m0 + r) * D + j * 512 + lane * 8; const f32x4 a = *(const GAS f32x4*)xr, b = *(const GAS f32x4*)(xr + 4);
                    xv[r][j * 8 + 0] = a.x; xv[r][j * 8 + 1] = a.y; xv[r][j * 8 + 2] = a.z; xv[r][j * 8 + 3] = a.w; xv[r][j * 8 + 4] = b.x; xv[r][j * 8 + 5] = b.y; xv[r][j * 8 + 6] = b.z; xv[r][j * 8 + 7] = b.w; }
        } else {
            v4u xw[RB][2];
#pragma unroll
            for (int r = 0; r < RB; ++r)
#pragma unroll
                for (int j = 0; j < 2; ++j) xw[r][j] = *(const GAS v4u*)(xb + (size_t)(m0 + r) * D + j * 512 + lane * 8);
#pragma unroll
            for (int r = 0; r < RB; ++r)
#pragma unroll
                for (int j = 0; j < 2; ++j) unpack8(&xv[r][j * 8], xw[r][j]);
        }
#pragma unroll
        for (int r = 0; r < RB; ++r) {
            float yv[16]; unpack8(yv, yw[r][0]); unpack8(yv + 8, yw[r][1]);
            float s = 0.f;
#pragma unroll
            for (int e = 0; e < 16; ++e) s += yv[e] * yv[e];
            const float ry = 1.0f / sqrtf(wave_sum(s) * (1.f / D) + NORM_EPS);
            float s2 = 0.f;
#pragma unroll
            for (int e = 0; e < 16; ++e) { xv[r][e] = xv[r][e] + yv[e] * ry * gp[e]; s2 += xv[r][e] * xv[r][e]; }
            if (out32) { float* xo = out32 + (size_t)(m0 + r) * D;
#pragma unroll
                for (int j = 0; j < 2; ++j) { *(GAS f32x4*)(xo + j * 512 + lane * 8) = (f32x4){xv[r][j * 8 + 0], xv[r][j * 8 + 1], xv[r][j * 8 + 2], xv[r][j * 8 + 3]};
                    *(GAS f32x4*)(xo + j * 512 + lane * 8 + 4) = (f32x4){xv[r][j * 8 + 4], xv[r][j * 8 + 5], xv[r][j * 8 + 6], xv[r][j * 8 + 7]}; } }
            else { s2 = wave_sum(s2); if (lane == 0) ssq[m0 + r] = s2;
#pragma unroll
                for (int j = 0; j < 2; ++j) { v4u o; o.x = pk2(xv[r][j * 8 + 0], xv[r][j * 8 + 1]); o.y = pk2(xv[r][j * 8 + 2], xv[r][j * 8 + 3]); o.z = pk2(xv[r][j * 8 + 4], xv[r][j * 8 + 5]); o.w = pk2(xv[r][j * 8 + 6], xv[r][j * 8 + 7]);
                    *(GAS v4u*)(xbo + (size_t)(m0 + r) * D + j * 512 + lane * 8) = o; } }
        }
    }
}
typedef float f32x16 __attribute__((ext_vector_type(16)));
typedef short s16x4 __attribute__((ext_vector_type(4)));
typedef float f32x2_t __attribute__((ext_vector_type(2)));
typedef __bf16 bf16x2_t __attribute__((ext_vector_type(2)));
#define MFMA32(a, b, c) __builtin_amdgcn_mfma_f32_32x32x16_bf16((a), (b), (c), 0, 0, 0)
__device__ __forceinline__ unsigned cvtpk(float lo, float hi) { f32x2_t v = {lo, hi}; bf16x2_t b = __builtin_convertvector(v, bf16x2_t); return __builtin_bit_cast(unsigned, b); }
__device__ __forceinline__ float ex2(float x) { return __builtin_amdgcn_exp2f(x); }
constexpr int KT_PITCH = 144, KT_BYTES = 64 * KT_PITCH, VT_BYTES = 8192;
constexpr int ATT_K0 = 0, ATT_V0 = 2 * KT_BYTES, ATT_LUT = ATT_V0 + 2 * VT_BYTES;
constexpr int LUT_PAD = 192;
constexpr float M_INIT = -5e29f;
struct TileRegs { v4u k, v; };
__device__ __forceinline__ void tile_gload(TileRegs& t, const bf16* kg, const bf16* vg, int pitchk, int pitchv, int tid) {
    const int row = tid >> 3, ch = tid & 7;
    t.k = *(const GAS v4u*)(kg + (size_t)row * pitchk + ch * 8);
    t.v = *(const GAS v4u*)(vg + (size_t)row * pitchv + ch * 8);
}
__device__ __forceinline__ void tile_swrite(const TileRegs& t, LAS unsigned char* kt, LAS unsigned char* vt, int tid) {
    const int row = tid >> 3, ch = tid & 7;
    *(LAS v4u*)(kt + row * KT_PITCH + ch * 16) = t.k;
    *(LAS v4u*)(vt + (ch >> 2) * 4096 + row * 64 + (ch & 3) * 16) = t.v;
}
__device__ __forceinline__ void tile_qk(const LAS unsigned char* kt, const bf16x8 (&qf)[4], f32x16& p0, f32x16& p1, int lane) {
    const LAS unsigned char* kp = kt + (lane & 31) * KT_PITCH + (lane >> 5) * 16;
#pragma unroll
    for (int r = 0; r < 16; ++r) { p0[r] = 0.f; p1[r] = 0.f; }
#pragma unroll
    for (int ks = 0; ks < 4; ++ks) {
        const bf16x8 a0 = *(const LAS bf16x8*)(kp + ks * 32), a1 = *(const LAS bf16x8*)(kp + 32 * KT_PITCH + ks * 32);
        p0 = MFMA32(a0, qf[ks], p0); p1 = MFMA32(a1, qf[ks], p1);
    }
}
__device__ __forceinline__ s16x4 vtr(const LAS unsigned char* p) { return __builtin_bit_cast(s16x4, __builtin_amdgcn_ds_read_tr16_b64_v4i16((LAS s16x4*)p)); }
__device__ __forceinline__ void tile_pv(const LAS unsigned char* vt, const f32x16& p0, const f32x16& p1, f32x16& o0, f32x16& o1, int lane) {
    const int hi = lane >> 5;
    const LAS unsigned char* vb = vt + ((lane >> 4) & 1) * 32 + (lane & 3) * 8 + (4 * hi + ((lane & 15) >> 2)) * 64;
#pragma unroll
    for (int ph = 0; ph < 2; ++ph)
#pragma unroll
        for (int s = 0; s < 2; ++s) {
            v4u w;
            if (ph == 0) { w.x = cvtpk(p0[8 * s + 0], p0[8 * s + 1]); w.y = cvtpk(p0[8 * s + 2], p0[8 * s + 3]); w.z = cvtpk(p0[8 * s + 4], p0[8 * s + 5]); w.w = cvtpk(p0[8 * s + 6], p0[8 * s + 7]); }
            else         { w.x = cvtpk(p1[8 * s + 0], p1[8 * s + 1]); w.y = cvtpk(p1[8 * s + 2], p1[8 * s + 3]); w.z = cvtpk(p1[8 * s + 4], p1[8 * s + 5]); w.w = cvtpk(p1[8 * s + 6], p1[8 * s + 7]); }
            const bf16x8 pf = __builtin_bit_cast(bf16x8, w);
            const int ks = 2 * ph + s;
            { const s16x4 lo = vtr(vb + ks * 1024), h2 = vtr(vb + ks * 1024 + 512);
              const bf16x8 vf = (bf16x8){lo[0], lo[1], lo[2], lo[3], h2[0], h2[1], h2[2], h2[3]}; o0 = MFMA32(vf, pf, o0); }
            { const s16x4 lo = vtr(vb + 4096 + ks * 1024), h2 = vtr(vb + 4096 + ks * 1024 + 512);
              const bf16x8 vf = (bf16x8){lo[0], lo[1], lo[2], lo[3], h2[0], h2[1], h2[2], h2[3]}; o1 = MFMA32(vf, pf, o1); }
        }
}
__device__ __forceinline__ void tile_softmax(f32x16& p0, f32x16& p1, const LAS float* rl, float sc, float& m, float& l, f32x16& o0, f32x16& o1) {
#pragma unroll
    for (int r = 0; r < 16; ++r) { const int c = 8 * (r >> 2) + (r & 3); p0[r] = fmaf(p0[r], sc, rl[c]); p1[r] = fmaf(p1[r], sc, rl[32 + c]); }
    float mx = fmaxf(p0[0], p1[0]);
#pragma unroll
    for (int r = 1; r < 16; ++r) mx = fmaxf(mx, fmaxf(p0[r], p1[r]));
    mx = fmaxf(mx, __shfl_xor(mx, 32));
    const float mn = fmaxf(m, mx), alpha = ex2(m - mn); m = mn;
    float ls = 0.f;
#pragma unroll
    for (int r = 0; r < 16; ++r) { p0[r] = ex2(p0[r] - mn); p1[r] = ex2(p1[r] - mn); ls += p0[r] + p1[r]; }
    l = l * alpha + ls;
    if (!__all(alpha == 1.0f)) {
#pragma unroll
        for (int r = 0; r < 16; ++r) { o0[r] *= alpha; o1[r] *= alpha; }
    }
}
__device__ __forceinline__ void load_qf(bf16x8 (&qf)[4], const bf16* qrow, int hi) {
#pragma unroll
    for (int ks = 0; ks < 4; ++ks) qf[ks] = *(const GAS bf16x8*)(qrow + 16 * ks + 8 * hi);
}
__device__ __forceinline__ void store_o(bf16* orow, const f32x16& o0, const f32x16& o1, int hi) {
#pragma unroll
    for (int a = 0; a < 4; ++a) {
        const unsigned long long w0 = (unsigned long long)cvtpk(o0[4 * a + 0], o0[4 * a + 1]) | ((unsigned long long)cvtpk(o0[4 * a + 2], o0[4 * a + 3]) << 32);
        const unsigned long long w1 = (unsigned long long)cvtpk(o1[4 * a + 0], o1[4 * a + 1]) | ((unsigned long long)cvtpk(o1[4 * a + 2], o1[4 * a + 3]) << 32);
        *(GAS unsigned long long*)(orow + 8 * a + 4 * hi) = w0; *(GAS unsigned long long*)(orow + 32 + 8 * a + 4 * hi) = w1;
    }
}

#define ABAR() do { asm volatile("s_waitcnt lgkmcnt(0)" ::: "memory"); __builtin_amdgcn_s_barrier(); asm volatile("" ::: "memory"); } while (0)
#define TILE_PIPELINE(NEXT, KPTR, VPTR, PITCH, ONWRITE, COMPUTE) do { \
    int j0_ = (NEXT); int j1_ = (NEXT); TileRegs ta_, tb_; \
    tile_gload(ta_, KPTR(j0_), VPTR(j0_), PITCH, PITCH, tid); if (j1_ >= 0) tile_gload(tb_, KPTR(j1_), VPTR(j1_), PITCH, PITCH, tid); \
    ONWRITE(j0_, ta_); tile_swrite(ta_, L + ATT_K0, L + ATT_V0, tid); ABAR(); \
    for (;;) { \
        int j2_ = j1_ >= 0 ? (NEXT) : -1; if (j2_ >= 0) tile_gload(ta_, KPTR(j2_), VPTR(j2_), PITCH, PITCH, tid); \
        COMPUTE(j0_, (L + ATT_K0), (L + ATT_V0)); \
        if (j1_ >= 0) { ONWRITE(j1_, tb_); tile_swrite(tb_, L + ATT_K0 + KT_BYTES, L + ATT_V0 + VT_BYTES, tid); } \
        ABAR(); if (j1_ < 0) break; \
        int j3_ = j2_ >= 0 ? (NEXT) : -1; if (j3_ >= 0) tile_gload(tb_, KPTR(j3_), VPTR(j3_), PITCH, PITCH, tid); \
        COMPUTE(j1_, (L + ATT_K0 + KT_BYTES), (L + ATT_V0 + VT_BYTES)); \
        if (j2_ >= 0) { ONWRITE(j2_, ta_); tile_swrite(ta_, L + ATT_K0, L + ATT_V0, tid); } \
        ABAR(); if (j2_ < 0) break; \
        j0_ = j2_; j1_ = j3_; \
    } } while (0)
#define NO_ONWRITE(j, t) do { } while (0)
constexpr float SC_LOG2 = 0.125f * LOG2E;
__device__ __forceinline__ void attn_phase_A(LAS unsigned char* L, const bf16* qkv, const float* lutg, const float* sinks, bf16* O, int G) {
    constexpr int DMAX = 191, LUTN = DMAX + 1 + LUT_PAD;
    LAS float* lut = (LAS float*)(L + ATT_LUT);
    for (int u = blockIdx.x; u < 2048; u += G) {
        int tid_ = threadIdx.x; asm volatile("" : "+v"(tid_));
        const int tid = tid_, lane = tid & 63, wave = __builtin_amdgcn_readfirstlane(tid >> 6), r32 = lane & 31, hi = lane >> 5;
        const int c = u & 31, hq = (u >> 5) & 1, g = (u >> 6) & 1, b = u >> 7;
        for (int i = tid; i < 4 * LUTN; i += 512) { const int hh = i / LUTN, k = i - hh * LUTN, dist = DMAX - k, h = 8 * g + 4 * hq + hh;
            lut[i] = (dist < 0 || dist >= 128) ? NEGF : lutg[h * 2048 + dist] * LOG2E; }
        const int hl = wave >> 1, h = 8 * g + 4 * hq + hl, tq = 64 * c + 32 * (wave & 1) + r32;
        const size_t tokq = (size_t)b * S + tq;
        bf16x8 qf[4]; load_qf(qf, qkv + tokq * A_IN + h * 64, hi);
        float m = M_INIT, l = 0.f; f32x16 o0, o1;
#pragma unroll
        for (int r = 0; r < 16; ++r) { o0[r] = 0.f; o1[r] = 0.f; }
        const bf16* kbase = qkv + (size_t)b * S * A_IN + 1024 + g * 64; const bf16* vbase = kbase + 128;
        const int kt0 = c >= 2 ? c - 2 : 0;
        int itn = kt0;
#define A_NEXT (itn <= c ? itn++ : -1)
#define A_KP(j) (kbase + (size_t)(64 * (j)) * A_IN)
#define A_VP(j) (vbase + (size_t)(64 * (j)) * A_IN)
#define A_COMPUTE(j, ktp, vtp) do { f32x16 p0, p1; tile_qk(ktp, qf, p0, p1, lane); \
            const LAS float* rl = lut + hl * LUTN + (DMAX - tq + 64 * (j) + 4 * hi); \
            tile_softmax(p0, p1, rl, SC_LOG2, m, l, o0, o1); tile_pv(vtp, p0, p1, o0, o1, lane); } while (0)
        TILE_PIPELINE(A_NEXT, A_KP, A_VP, A_IN, NO_ONWRITE, A_COMPUTE);
#undef A_NEXT
#undef A_KP
#undef A_VP
#undef A_COMPUTE
        const float lt = l + __shfl_xor(l, 32);
        const float inv = 1.0f / (lt + ex2(sinks[h] * LOG2E - m));
#pragma unroll
        for (int r = 0; r < 16; ++r) { o0[r] *= inv; o1[r] *= inv; }
        store_o(O + tokq * D + h * 64, o0, o1, hi);
    }
}
__device__ __forceinline__ void attn_phase_C(LAS unsigned char* L, const bf16* qkv, const float* lutg, bf16* O, int G) {
    constexpr int DMAX = 2047, LUTN = DMAX + 1 + LUT_PAD;
    LAS float* lut = (LAS float*)(L + ATT_LUT);
    LAS float* KM = (LAS float*)(L + ATT_LUT + 9216);
    LAS float* PART = KM + 512;
    for (int bh = blockIdx.x; bh < 256; bh += G) {
        const int b = bh >> 4, h = bh & 15;
        for (int i = threadIdx.x; i < LUTN; i += 512) { const int dist = DMAX - i; lut[i] = dist < 0 ? NEGF : lutg[h * 2048 + dist] * LOG2E; }
        const bf16* kbase = qkv + (size_t)b * S * C_IN + 1024 + h * 64; const bf16* vbase = kbase + 1024;
        for (int c = 0; c < 8; ++c) {
            int tid_ = threadIdx.x; asm volatile("" : "+v"(tid_));
            const int tid = tid_, lane = tid & 63, wave = __builtin_amdgcn_readfirstlane(tid >> 6), r32 = lane & 31, hi = lane >> 5;
            const int tq = 256 * c + 32 * wave + r32; const size_t tokq = (size_t)b * S + tq;
            bf16x8 qf[4]; load_qf(qf, qkv + tokq * C_IN + h * 64, hi);
            unsigned selm = 0u;
            if (c > 0) {
                float gv[7];
#pragma unroll
                for (int n = 0; n < 7; ++n) {
                    float s = -3e38f;
                    if (n < c) { s = 0.f;
#pragma unroll
                        for (int ks = 0; ks < 4; ++ks)
#pragma unroll
                            for (int j = 0; j < 8; ++j) s += bf2f((bf16)qf[ks][j]) * KM[n * 64 + 16 * ks + 8 * hi + j];
                        s += __shfl_xor(s, 32); }
                    gv[n] = s; }
                if (c <= 3) selm = (1u << c) - 1u;
                else {
#pragma unroll
                    for (int rnd = 0; rnd < 3; ++rnd) { int best = 0; float bv = gv[0];
#pragma unroll
                        for (int n = 1; n < 7; ++n) if (gv[n] > bv) { bv = gv[n]; best = n; }
                        selm |= 1u << best;
#pragma unroll
                        for (int n = 0; n < 7; ++n) gv[n] = (n == best) ? -3e38f : gv[n]; }
                }
            }
            float m = M_INIT, l = 0.f; f32x16 o0, o1;
#pragma unroll
            for (int r = 0; r < 16; ++r) { o0[r] = 0.f; o1[r] = 0.f; }
            float cs[8];
#pragma unroll
            for (int j = 0; j < 8; ++j) cs[j] = 0.f;
#define CS_ACC(t) do { cs[0] += bflo((t).k.x); cs[1] += bfhi((t).k.x); cs[2] += bflo((t).k.y); cs[3] += bfhi((t).k.y); cs[4] += bflo((t).k.z); cs[5] += bfhi((t).k.z); cs[6] += bflo((t).k.w); cs[7] += bfhi((t).k.w); } while (0)
            const int n = 4 + 4 * c; int itn = 0;
#define C_NEXT (itn < n ? itn++ : -1)
#define C_KT(i) ((i) < 4 ? 4 * c + (i) : (i) - 4)
#define C_KP(i) (kbase + (size_t)(64 * C_KT(i)) * C_IN)
#define C_VP(i) (vbase + (size_t)(64 * C_KT(i)) * C_IN)
#define C_ONWRITE(i, t) do { if ((i) < 4) CS_ACC(t); } while (0)
#define C_COMPUTE(i, ktp, vtp) do { const bool need = (i) < 4 ? ((i) <= (wave >> 1)) : true; \
                if (need) { const bool lsel = (i) < 4 ? true : (((selm >> (((i) - 4) >> 2)) & 1u) != 0u); \
                    f32x16 p0, p1; tile_qk(ktp, qf, p0, p1, lane); \
                    const LAS float* rl = lut + (lsel ? (DMAX - tq + 64 * C_KT(i) + 4 * hi) : (DMAX + 64)); \
                    tile_softmax(p0, p1, rl, SC_LOG2, m, l, o0, o1); tile_pv(vtp, p0, p1, o0, o1, lane); } } while (0)
            TILE_PIPELINE(C_NEXT, C_KP, C_VP, C_IN, C_ONWRITE, C_COMPUTE);
#undef C_NEXT
#undef C_KT
#undef C_KP
#undef C_VP
#undef C_ONWRITE
#undef C_COMPUTE
#undef CS_ACC
#pragma unroll
            for (int j = 0; j < 8; ++j) { float v = cs[j]; v += __shfl_xor(v, 8); v += __shfl_xor(v, 16); v += __shfl_xor(v, 32); cs[j] = v; }
            if (lane < 8) {
#pragma unroll
                for (int j = 0; j < 8; ++j) PART[wave * 64 + lane * 8 + j] = cs[j]; }
            __syncthreads();
            if (tid < 64) { float s = 0.f;
#pragma unroll
                for (int w = 0; w < 8; ++w) s += PART[w * 64 + tid];
                KM[c * 64 + tid] = s; }
            __syncthreads();
            const float lt = l + __shfl_xor(l, 32);
            const float inv = 1.0f / lt;
#pragma unroll
            for (int r = 0; r < 16; ++r) { o0[r] *= inv; o1[r] *= inv; }
            store_o(O + tokq * D + h * 64, o0, o1, hi);
        }
    }
}
__device__ __forceinline__ float gelu_tanh(float x) {
    const float z = 0.7978845608028654f * (x + 0.044715f * x * x * x);
    const float e = ex2(2.0f * LOG2E * z);
    const float t = 1.0f - 2.0f * __builtin_amdgcn_rcpf(1.0f + e);
    return 0.5f * x * (1.0f + t);
}
__device__ __forceinline__ void compress_phase(LAS unsigned char* L, const bf16* qkv, const bf16* w1t, const bf16* w2t, const float* bias1, bf16* kcb, bf16* vcb, int G) {
    constexpr int AP = 144, HP = 528;
    LAS unsigned char* AT = L; LAS unsigned char* H1 = L + 2 * 64 * AP;
    for (int u = blockIdx.x; u < 256; u += G) {
        int tid_ = threadIdx.x; asm volatile("" : "+v"(tid_));
        const int tid = tid_, lane = tid & 63, wave = __builtin_amdgcn_readfirstlane(tid >> 6), r32 = lane & 31, hi = lane >> 5;
        const int nh = u & 1, kv = (u >> 1) & 1, g = (u >> 2) & 3, b = u >> 4;
        const int arow = tid >> 3, ach = tid & 7; int n_ld = 64 * nh + arow; if (n_ld > 126) n_ld = 126;
        const bf16* abase = qkv + ((size_t)b * S + 16 * n_ld) * B_INP + 1024 + kv * 256 + g * 64 + 8 * ach;
        const bf16* bbase = w1t + ((size_t)kv * 256 + 32 * wave + r32) * 2048 + 8 * hi;
        f32x16 acc0, acc1;
#pragma unroll
        for (int r = 0; r < 16; ++r) { acc0[r] = 0.f; acc1[r] = 0.f; }
        v4u areg = *(const GAS v4u*)abase; bf16x8 breg[4];
#pragma unroll
        for (int ks = 0; ks < 4; ++ks) breg[ks] = *(const GAS bf16x8*)(bbase + 16 * ks);
        *(LAS v4u*)(AT + arow * AP + ach * 16) = areg;
        __syncthreads();
        for (int l = 0; l < 32; ++l) {
            const int buf = l & 1; v4u an = areg; bf16x8 bn[4];
#pragma unroll
            for (int ks = 0; ks < 4; ++ks) bn[ks] = breg[ks];
            if (l + 1 < 32) { an = *(const GAS v4u*)(abase + (size_t)(l + 1) * B_INP);
#pragma unroll
                for (int ks = 0; ks < 4; ++ks) bn[ks] = *(const GAS bf16x8*)(bbase + (l + 1) * 64 + 16 * ks); }
            const LAS unsigned char* ap = AT + buf * 64 * AP + r32 * AP + hi * 16;
#pragma unroll
            for (int ks = 0; ks < 4; ++ks) { const bf16x8 a0 = *(const LAS bf16x8*)(ap + ks * 32), a1 = *(const LAS bf16x8*)(ap + 32 * AP + ks * 32);
                acc0 = MFMA32(a0, breg[ks], acc0); acc1 = MFMA32(a1, breg[ks], acc1); }
            if (l + 1 < 32) *(LAS v4u*)(AT + (buf ^ 1) * 64 * AP + arow * AP + ach * 16) = an;
#pragma unroll
            for (int ks = 0; ks < 4; ++ks) breg[ks] = bn[ks];
            __syncthreads();
        }
        float bias = 0.f;
#pragma unroll
        for (int kc = 0; kc < 16; ++kc) bias += bias1[(kv * 16 + kc) * 256 + 32 * wave + r32];
#pragma unroll
        for (int r = 0; r < 16; ++r) { const int row = (r & 3) + 8 * (r >> 2) + 4 * hi;
            *(LAS bf16*)(H1 + row * HP + (32 * wave + r32) * 2) = (bf16)f2bf(gelu_tanh(acc0[r] + bias));
            *(LAS bf16*)(H1 + (row + 32) * HP + (32 * wave + r32) * 2) = (bf16)f2bf(gelu_tanh(acc1[r] + bias)); }
        __syncthreads();
        if (wave < 4) { const int rt = wave >> 1, ct = wave & 1; f32x16 acc;
#pragma unroll
            for (int r = 0; r < 16; ++r) acc[r] = 0.f;
#pragma unroll 4
            for (int ks = 0; ks < 16; ++ks) { const bf16x8 a = *(const LAS bf16x8*)(H1 + (32 * rt + r32) * HP + (16 * ks + 8 * hi) * 2);
                const bf16x8 bb = *(const GAS bf16x8*)(w2t + ((size_t)kv * 64 + 32 * ct + r32) * 256 + 16 * ks + 8 * hi); acc = MFMA32(a, bb, acc); }
            bf16* dst = (kv ? vcb : kcb) + (size_t)(b * 4 + g) * 128 * 64;
#pragma unroll
            for (int r = 0; r < 16; ++r) { const int n = 64 * nh + 32 * rt + (r & 3) + 8 * (r >> 2) + 4 * hi;
                dst[(size_t)n * 64 + 32 * ct + r32] = n < 127 ? (bf16)f2bf(acc[r]) : (bf16)0; } }
        __syncthreads();
    }
}
__device__ __forceinline__ int sel_pop(unsigned& rem) { const int j = __builtin_ctz(rem); rem &= rem - 1u; return j; }
__device__ __forceinline__ void attn_phase_B(LAS unsigned char* L, const bf16* qkv, const float* lutg, const bf16* kcb, const bf16* vcb, bf16* O, int G) {
    int tid0_ = threadIdx.x; asm volatile("" : "+v"(tid0_));
    const int tid0 = tid0_;
    constexpr int DS = 2047, LS = DS + 1 + LUT_PAD, DW = 575, LW = DW + 1 + LUT_PAD;
    LAS float* lutS = (LAS float*)(L + ATT_LUT);
    LAS float* lutW = lutS + 4 * LS;
    LAS float* IMPH = lutW + 4 * LW;
    LAS unsigned* SEL = (LAS unsigned*)(IMPH + 4 * 64 * 32);
    LAS unsigned* UNI = SEL + 64;
    LAS unsigned char* const K0 = L + ATT_K0; LAS unsigned char* const V0 = L + ATT_V0;
    for (int v = blockIdx.x; v < 256; v += G) {
        const int bg = v >> 2, jq = v & 3, b = bg >> 2, g = bg & 3;
        for (int i = tid0; i < 4 * LS; i += 512) { const int hh = i / LS, k = i - hh * LS, dist = DS - k; lutS[i] = dist < 0 ? NEGF : lutg[(4 * g + hh) * 2048 + dist] * LOG2E; }
        for (int i = tid0; i < 4 * LW; i += 512) { const int hh = i / LW, k = i - hh * LW, dist = DW - k; lutW[i] = (dist < 0 || dist >= 512) ? NEGF : lutg[(4 * g + hh) * 2048 + dist] * LOG2E; }
        const bf16* kc = kcb + (size_t)bg * 128 * 64; const bf16* vc = vcb + (size_t)bg * 128 * 64;
        const bf16* rowb = qkv + (size_t)b * S * B_INP;
        for (int ci = 0; ci < 8; ++ci) {
            int tid_ = threadIdx.x; asm volatile("" : "+v"(tid_));
            const int tid = tid_, lane = tid & 63, wave = __builtin_amdgcn_readfirstlane(tid >> 6), r32 = lane & 31, hi = lane >> 5;
            const int pr = ci >> 1, cb = pr == 0 ? jq : (pr == 1 ? 7 - jq : (pr == 2 ? 8 + jq : 15 - jq)), c = (ci & 1) ? 31 - cb : cb;
            const int hl = wave >> 1, h = 4 * g + hl, tl = 32 * (wave & 1) + r32, tq = 64 * c + tl;
            const size_t tokq = (size_t)b * S + tq;
            bf16x8 qf[4]; load_qf(qf, qkv + tokq * B_INP + h * 64, hi);
            float gt0, gt1, gt2;
            { const bf16* gp = qkv + tokq * B_INP + 2560 + h * 3;
              gt0 = __builtin_amdgcn_rcpf(1.f + ex2(-LOG2E * bf2f(gp[0]))); gt1 = __builtin_amdgcn_rcpf(1.f + ex2(-LOG2E * bf2f(gp[1]))); gt2 = __builtin_amdgcn_rcpf(1.f + ex2(-LOG2E * bf2f(gp[2]))); }
            if (tid == 0) UNI[0] = 0u;
            f32x16 ot0, ot1;
            { TileRegs t0, t1; tile_gload(t0, kc, vc, 64, 64, tid); tile_gload(t1, kc + 64 * 64, vc + 64 * 64, 64, 64, tid);
              tile_swrite(t0, K0, V0, tid); tile_swrite(t1, K0 + KT_BYTES, V0 + VT_BYTES, tid); }
            __syncthreads();
            {
                f32x16 sa, sb, sc, sd; tile_qk(K0, qf, sa, sb, lane); tile_qk(K0 + KT_BYTES, qf, sc, sd, lane);
                const int nmax = (tq - 31) >> 4;
                float mx = NEGF;
#pragma unroll
                for (int r = 0; r < 16; ++r) { const int nb = 8 * (r >> 2) + 4 * hi + (r & 3);
                    sa[r] = (nb <= nmax) ? sa[r] * SC_LOG2 : NEGF; sb[r] = (nb + 32 <= nmax) ? sb[r] * SC_LOG2 : NEGF;
                    sc[r] = (nb + 64 <= nmax) ? sc[r] * SC_LOG2 : NEGF; sd[r] = (nb + 96 <= nmax) ? sd[r] * SC_LOG2 : NEGF;
                    mx = fmaxf(fmaxf(mx, fmaxf(sa[r], sb[r])), fmaxf(sc[r], sd[r])); }
                mx = fmaxf(mx, __shfl_xor(mx, 32));
                const float mn = fmaxf(M_INIT, mx);
                float ls = 0.f;
#pragma unroll
                for (int r = 0; r < 16; ++r) { sa[r] = ex2(sa[r] - mn); sb[r] = ex2(sb[r] - mn); sc[r] = ex2(sc[r] - mn); sd[r] = ex2(sd[r] - mn); ls += (sa[r] + sb[r]) + (sc[r] + sd[r]); }
                const float lt = ls + __shfl_xor(ls, 32);
                const float inv = lt > 0.f ? 1.0f / lt : 0.f;
#pragma unroll
                for (int r = 0; r < 16; ++r) { sa[r] *= inv; sb[r] *= inv; sc[r] *= inv; sd[r] *= inv; }
                f32x16 oc0, oc1;
#pragma unroll
                for (int r = 0; r < 16; ++r) { oc0[r] = 0.f; oc1[r] = 0.f; }
                tile_pv(V0, sa, sb, oc0, oc1, lane); tile_pv(V0 + VT_BYTES, sc, sd, oc0, oc1, lane);
#pragma unroll
                for (int r = 0; r < 16; ++r) { ot0[r] = gt0 * oc0[r]; ot1[r] = gt0 * oc1[r]; }
                float core[16], last[16];
#pragma unroll
                for (int a = 0; a < 4; ++a) {
                    core[a] = (sa[4 * a] + sa[4 * a + 1]) + (sa[4 * a + 2] + sa[4 * a + 3]); last[a] = sa[4 * a + 3];
                    core[4 + a] = (sb[4 * a] + sb[4 * a + 1]) + (sb[4 * a + 2] + sb[4 * a + 3]); last[4 + a] = sb[4 * a + 3];
                    core[8 + a] = (sc[4 * a] + sc[4 * a + 1]) + (sc[4 * a + 2] + sc[4 * a + 3]); last[8 + a] = sc[4 * a + 3];
                    core[12 + a] = (sd[4 * a] + sd[4 * a + 1]) + (sd[4 * a + 2] + sd[4 * a + 3]); last[12 + a] = sd[4 * a + 3]; }
                float prev = 0.f;
                LAS float* ip = IMPH + (hl * 64 + tl) * 32 + hi;
#pragma unroll
                for (int mm = 0; mm < 16; ++mm) { const float rc = __shfl_xor(last[mm], 32);
                    ip[2 * mm] = core[mm] + (hi ? rc : prev); prev = rc; }
            }
            __syncthreads();
            { unsigned uw = 0u;
#pragma unroll
              for (int rnd = 0; rnd < 4; ++rnd) { const int tk = lane >> 5, j = lane & 31, t2 = 8 * wave + 2 * rnd + tk;
                  const float imp = ((IMPH[(0 * 64 + t2) * 32 + j] + IMPH[(1 * 64 + t2) * 32 + j]) + IMPH[(2 * 64 + t2) * 32 + j]) + IMPH[(3 * 64 + t2) * 32 + j];
                  const bool forced = (j == 0) || (j == c) || (j == c - 1);
                  const float val = j > c ? NEGF : (forced ? 1e30f : imp);
                  int rank = 0;
                  for (int i = 0; i < 32; ++i) { const float vi = __shfl(val, (lane & 32) + i); rank += (vi > val || (vi == val && i < j)) ? 1 : 0; }
                  const unsigned long long bal = __ballot(rank < 16);
                  const unsigned msk = tk ? (unsigned)(bal >> 32) : (unsigned)bal;
                  if (j == 0) SEL[t2] = msk;
                  uw |= (unsigned)bal | (unsigned)(bal >> 32); }
              if (lane == 0) atomicOr((unsigned*)UNI, uw); }
            __syncthreads();
            const unsigned mysel = SEL[tl];
            const unsigned uni = (unsigned)__builtin_amdgcn_readfirstlane((int)UNI[0]) & ((2u << c) - 1u);
            {
                float m = M_INIT, l = 0.f; f32x16 o0, o1;
#pragma unroll
                for (int r = 0; r < 16; ++r) { o0[r] = 0.f; o1[r] = 0.f; }
                const bf16* kbase = rowb + 1536 + g * 64; const bf16* vbase = rowb + 1792 + g * 64;
                unsigned rem = uni;
#define S_NEXT (rem ? sel_pop(rem) : -1)
#define S_KP(j) (kbase + (size_t)(64 * (j)) * B_INP)
#define S_VP(j) (vbase + (size_t)(64 * (j)) * B_INP)
#define S_COMPUTE(j, ktp, vtp) do { const bool lsel = ((mysel >> (j)) & 1u) != 0u; \
                    f32x16 p0, p1; tile_qk(ktp, qf, p0, p1, lane); \
                    const LAS float* rl = lutS + hl * LS + (lsel ? (DS - tq + 64 * (j) + 4 * hi) : (DS + 64)); \
                    tile_softmax(p0, p1, rl, SC_LOG2, m, l, o0, o1); tile_pv(vtp, p0, p1, o0, o1, lane); } while (0)
                TILE_PIPELINE(S_NEXT, S_KP, S_VP, B_INP, NO_ONWRITE, S_COMPUTE);
#undef S_NEXT
#undef S_COMPUTE
                const float lt = l + __shfl_xor(l, 32);
                const float f = gt1 / lt;
#pragma unroll
                for (int r = 0; r < 16; ++r) { ot0[r] += f * o0[r]; ot1[r] += f * o1[r]; }
            }
            {
                float m = M_INIT, l = 0.f; f32x16 o0, o1;
#pragma unroll
                for (int r = 0; r < 16; ++r) { o0[r] = 0.f; o1[r] = 0.f; }
                const bf16* kbase = rowb + 2048 + g * 64; const bf16* vbase = rowb + 2304 + g * 64;
                const int kt0 = c >= 8 ? c - 8 : 0; int itn = kt0;
#define W_NEXT (itn <= c ? itn++ : -1)
#define W_COMPUTE(j, ktp, vtp) do { f32x16 p0, p1; tile_qk(ktp, qf, p0, p1, lane); \
                    const LAS float* rl = lutW + hl * LW + (DW - tq + 64 * (j) + 4 * hi); \
                    tile_softmax(p0, p1, rl, SC_LOG2, m, l, o0, o1); tile_pv(vtp, p0, p1, o0, o1, lane); } while (0)
                TILE_PIPELINE(W_NEXT, S_KP, S_VP, B_INP, NO_ONWRITE, W_COMPUTE);
#undef W_NEXT
#undef W_COMPUTE
#undef S_KP
#undef S_VP
                const float lt = l + __shfl_xor(l, 32);
                const float f = gt2 / lt;
#pragma unroll
                for (int r = 0; r < 16; ++r) { ot0[r] += f * o0[r]; ot1[r] += f * o1[r]; }
            }
            store_o(O + tokq * D + h * 64, ot0, ot1, hi);
        }
    }
}
#if defined(NAIVE_ATTN)
__device__ __forceinline__ float dot64_lds(const float* qs, const bf16* kr) {
    float s = 0.f;
#pragma unroll
    for (int c = 0; c < 8; ++c) { const v4u w = *(const v4u*)(kr + 8 * c);
        s += qs[8 * c + 0] * bflo(w.x) + qs[8 * c + 1] * bfhi(w.x) + qs[8 * c + 2] * bflo(w.y) + qs[8 * c + 3] * bfhi(w.y) + qs[8 * c + 4] * bflo(w.z) + qs[8 * c + 5] * bfhi(w.z) + qs[8 * c + 6] * bflo(w.w) + qs[8 * c + 7] * bfhi(w.w); }
    return s;
}
__global__ void __launch_bounds__(256) naive_compress(const bf16* qkv, const float* pos, const float* w1, const float* w2, bf16* kcb, bf16* vcb) {
    const int id = blockIdx.x, kv = id & 1, g = (id >> 1) & 3, rest = id >> 3, n = rest % 127, b = rest / 127, tid = threadIdx.x;
    __shared__ float flat[2048]; __shared__ float h1[256];
    const int col0 = 1024 + kv * 256 + g * 64;
    for (int i = tid; i < 2048; i += 256) { const int l = i >> 6, d = i & 63; flat[i] = bf2f(qkv[(size_t)(b * S + 16 * n + l) * B_INP + col0 + d]) + pos[kv * 2048 + i]; }
    __syncthreads();
    float acc = 0.f;
    for (int k = 0; k < 2048; ++k) acc += flat[k] * w1[((size_t)kv * 2048 + k) * 256 + tid];
    { const float x = acc; const float t = tanhf(0.7978845608028654f * (x + 0.044715f * x * x * x)); h1[tid] = 0.5f * x * (1.f + t); }
    __syncthreads();
    bf16* dst = kv ? vcb : kcb;
    if (tid < 64) { float o = 0.f; for (int c = 0; c < 256; ++c) o += h1[c] * w2[((size_t)kv * 256 + c) * 64 + tid];
        dst[((size_t)(b * 4 + g) * 128 + n) * 64 + tid] = (bf16)f2bf(o);
        if (n == 126) dst[((size_t)(b * 4 + g) * 128 + 127) * 64 + tid] = 0; }
}
__global__ void __launch_bounds__(64) naive_attn_A(const bf16* qkv, const float* lutg, const float* sinks, bf16* o) {
    const int idx = blockIdx.x, h = idx & 15, tok = idx >> 4, b = tok >> 11, t = tok & 2047, g = h >> 3, lane = threadIdx.x;
    __shared__ float qs[64];
    qs[lane] = bf2f(qkv[(size_t)tok * A_IN + h * 64 + lane]); __syncthreads();
    float sc[2]; bool va[2];
_Pragma("unroll") for (int w = 0; w < 2; ++w) { const int dist = lane + 64 * w, s = t - dist; va[w] = s >= 0;
        sc[w] = va[w] ? dot64_lds(qs, qkv + (size_t)(b * S + s) * A_IN + 1024 + g * 64) * 0.125f + lutg[h * 2048 + dist] : NEGF; }
    const float sink = sinks[h];
    const float m = fmaxf(wave_max(fmaxf(sc[0], sc[1])), sink);
    float e[2]; e[0] = va[0] ? expf(sc[0] - m) : 0.f; e[1] = va[1] ? expf(sc[1] - m) : 0.f;
    const float den = fmaxf(wave_sum(e[0] + e[1]) + expf(sink - m), 1e-30f);
    float out = 0.f;
_Pragma("unroll") for (int w = 0; w < 2; ++w) for (int l = 0; l < 64; ++l) { const float pl = __shfl(e[w], l) / den; const int sl = t - l - 64 * w; if (sl >= 0) out += pl * bf2f(qkv[(size_t)(b * S + sl) * A_IN + 1152 + g * 64 + lane]); }
    o[(size_t)tok * D + h * 64 + lane] = (bf16)f2bf(out);
}
__global__ void __launch_bounds__(64) naive_kmean(const bf16* qkv, float* kmean) {
    const int id = blockIdx.x, h = id & 15, n = (id >> 4) & 7, b = id >> 7, lane = threadIdx.x;
    float s = 0.f; for (int i = 0; i < 256; ++i) s += bf2f(qkv[(size_t)(b * S + 256 * n + i) * C_IN + 1024 + h * 64 + lane]);
    kmean[(size_t)id * 64 + lane] = s * (1.f / 256.f);
}
__global__ void __launch_bounds__(64) naive_attn_C(const bf16* qkv, const float* lutg, const float* kmean, bf16* o) {
    const int idx = blockIdx.x, h = idx & 15, tok = idx >> 4, b = tok >> 11, t = tok & 2047, c = t >> 8, lane = threadIdx.x;
    __shared__ float qs[64]; __shared__ float sc[1024];
    qs[lane] = bf2f(qkv[(size_t)tok * C_IN + h * 64 + lane]); __syncthreads();
    float gate[8];
#pragma unroll
    for (int n = 0; n < 8; ++n) { float s = NEGF; if (n < c) { s = 0.f; const float* km = kmean + ((size_t)((b * 8 + n) * 16 + h)) * 64; for (int d = 0; d < 64; ++d) s += qs[d] * km[d]; } gate[n] = s; }
    int selb[3];
#pragma unroll
    for (int r = 0; r < 3; ++r) { int best = 0; float bv = gate[0];
#pragma unroll
        for (int n = 1; n < 8; ++n) if (gate[n] > bv) { bv = gate[n]; best = n; }
        selb[r] = best;
#pragma unroll
        for (int n = 0; n < 8; ++n) if (n == best) gate[n] = -3e38f; }
    float mx = NEGF;
    _Pragma("unroll") for (int sl = 0; sl < 4; ++sl) { const int blk = sl == 0 ? c : selb[sl - 1]; const bool bok = sl == 0 || blk < c;
        _Pragma("unroll") for (int w = 0; w < 4; ++w) { const int i = lane + 64 * w, s = 256 * blk + i, dist = t - s; const bool ok = bok && dist >= 0;
            float v = NEGF; if (ok) v = dot64_lds(qs, qkv + (size_t)(b * S + s) * C_IN + 1024 + h * 64) * 0.125f + lutg[h * 2048 + dist];
            sc[sl * 256 + i] = v; mx = fmaxf(mx, v); } }
    mx = wave_max(mx); __syncthreads();
    float den = 0.f;
    for (int k = lane; k < 1024; k += 64) { const float v = sc[k]; const float e = v > -1e29f ? expf(v - mx) : 0.f; sc[k] = e; den += e; }
    den = fmaxf(wave_sum(den), 1e-30f); __syncthreads();
    float out = 0.f;
    _Pragma("unroll") for (int sl = 0; sl < 4; ++sl) { const int blk = sl == 0 ? c : selb[sl - 1]; const bool bok = sl == 0 || blk < c; if (!bok) continue;
        for (int i = 0; i < 256; ++i) { const float p = sc[sl * 256 + i]; if (p != 0.f) out += p * bf2f(qkv[(size_t)(b * S + 256 * blk + i) * C_IN + 2048 + h * 64 + lane]); } }
    o[(size_t)tok * D + h * 64 + lane] = (bf16)f2bf(out / den);
}
__global__ void __launch_bounds__(64) naive_attn_B(const bf16* qkv, const float* lutg, const bf16* kcb, const bf16* vcb, bf16* o) {
    const int id = blockIdx.x, g = id & 3, tok = id >> 2, b = tok >> 11, t = tok & 2047, lane = threadIdx.x, cur = t >> 6;
    __shared__ float qs[4][64]; __shared__ float pc[4][128]; __shared__ float scs[4][1024]; __shared__ float scw[4][512];
    _Pragma("unroll") for (int r = 0; r < 4; ++r) qs[r][lane] = bf2f(qkv[(size_t)tok * B_INP + (4 * g + r) * 64 + lane]);
    __syncthreads();
    float otot[4] = {0.f, 0.f, 0.f, 0.f};
    float gt[4][3];
    _Pragma("unroll") for (int r = 0; r < 4; ++r) _Pragma("unroll") for (int i = 0; i < 3; ++i) { const float z = bf2f(qkv[(size_t)tok * B_INP + 2560 + (4 * g + r) * 3 + i]); gt[r][i] = 1.f / (1.f + expf(-z)); }
    const int nvalid = t >= 31 ? ((t - 31) >> 4) + 1 : 0;
    const bf16* kc = kcb + (size_t)(b * 4 + g) * 128 * 64; const bf16* vc = vcb + (size_t)(b * 4 + g) * 128 * 64;
    _Pragma("unroll") for (int r = 0; r < 4; ++r) { float s2[2]; bool va[2];
        _Pragma("unroll") for (int w = 0; w < 2; ++w) { const int n = lane + 64 * w; va[w] = n < nvalid; s2[w] = va[w] ? dot64_lds(qs[r], kc + (size_t)n * 64) * 0.125f : NEGF; }
        const float m = wave_max(fmaxf(s2[0], s2[1]));
        float e0 = va[0] ? expf(s2[0] - m) : 0.f, e1 = va[1] ? expf(s2[1] - m) : 0.f;
        const float den = fmaxf(wave_sum(e0 + e1), 1e-30f);
        pc[r][lane] = e0 / den; pc[r][lane + 64] = e1 / den; }
    __syncthreads();
    _Pragma("unroll") for (int r = 0; r < 4; ++r) { float a = 0.f; for (int n = 0; n < 127; ++n) a += pc[r][n] * bf2f(vc[(size_t)n * 64 + lane]); otot[r] += gt[r][0] * a; }
    float val = -3e38f;
    if (lane < 32) { const int j = lane; float imp = 0.f;
        _Pragma("unroll") for (int r = 0; r < 4; ++r) for (int n = 4 * j - 1; n <= 4 * j + 3; ++n) if (n >= 0 && n <= 126) imp += pc[r][n];
        const bool forced = (j == 0) || (j == cur) || (j == cur - 1);
        val = j > cur ? NEGF : (forced ? 1e30f : imp); }
    int rank = 0;
    for (int i = 0; i < 32; ++i) { const float vi = __shfl(val, i); rank += (vi > val || (vi == val && i < lane)) ? 1 : 0; }
    const unsigned long long bal = __ballot(lane < 32 && rank < 16);
    const unsigned selmask = (unsigned)bal;
    { int slot = 0; float mx[4] = {NEGF, NEGF, NEGF, NEGF};
      for (int jb = 0; jb < 32; ++jb) { if (!((selmask >> jb) & 1u)) continue;
          const int s = 64 * jb + lane, dist = t - s; const bool ok = dist >= 0;
          _Pragma("unroll") for (int r = 0; r < 4; ++r) { float v = NEGF; if (ok) v = dot64_lds(qs[r], qkv + (size_t)(b * S + s) * B_INP + 1536 + g * 64) * 0.125f + lutg[(4 * g + r) * 2048 + dist];
              scs[r][slot * 64 + lane] = v; mx[r] = fmaxf(mx[r], v); }
          ++slot; }
      __syncthreads();
      _Pragma("unroll") for (int r = 0; r < 4; ++r) { const float m = wave_max(mx[r]); float den = 0.f;
          for (int k = lane; k < 1024; k += 64) { const float v = scs[r][k]; const float e = v > -1e29f ? expf(v - m) : 0.f; scs[r][k] = e; den += e; }
          den = fmaxf(wave_sum(den), 1e-30f); __syncthreads();
          float a = 0.f; int sl2 = 0;
          for (int jb = 0; jb < 32; ++jb) { if (!((selmask >> jb) & 1u)) continue;
              for (int i = 0; i < 64; ++i) { const float p = scs[r][sl2 * 64 + i]; if (p != 0.f) a += p * bf2f(qkv[(size_t)(b * S + 64 * jb + i) * B_INP + 1792 + g * 64 + lane]); }
              ++sl2; }
          otot[r] += gt[r][1] * a / den; } }
    { float mx[4] = {NEGF, NEGF, NEGF, NEGF};
      _Pragma("unroll") for (int w = 0; w < 8; ++w) { const int dist = lane + 64 * w, s = t - dist; const bool ok = s >= 0;
          _Pragma("unroll") for (int r = 0; r < 4; ++r) { float v = NEGF; if (ok) v = dot64_lds(qs[r], qkv + (size_t)(b * S + s) * B_INP + 2048 + g * 64) * 0.125f + lutg[(4 * g + r) * 2048 + dist];
              scw[r][dist] = v; mx[r] = fmaxf(mx[r], v); } }
      __syncthreads();
      _Pragma("unroll") for (int r = 0; r < 4; ++r) { const float m = wave_max(mx[r]); float den = 0.f;
          for (int k = lane; k < 512; k += 64) { const float v = scw[r][k]; const float e = v > -1e29f ? expf(v - m) : 0.f; scw[r][k] = e; den += e; }
          den = fmaxf(wave_sum(den), 1e-30f); __syncthreads();
          float a = 0.f;
          for (int i = 0; i < 512; ++i) { const float p = scw[r][i]; if (p != 0.f) a += p * bf2f(qkv[(size_t)(b * S + t - i) * B_INP + 2304 + g * 64 + lane]); }
          otot[r] += gt[r][2] * a / den; } }
    _Pragma("unroll") for (int r = 0; r < 4; ++r) o[(size_t)tok * D + (4 * g + r) * 64 + lane] = (bf16)f2bf(otot[r]);
}
#endif
#ifndef REP_PRO
#define REP_PRO 1
#endif
#ifndef REP_G1
#define REP_G1 1
#endif
#ifndef REP_G2
#define REP_G2 1
#endif
#ifndef REP_QKV
#define REP_QKV 1
#endif
#ifndef REP_ATT
#define REP_ATT 1
#endif
#ifndef REP_CMP
#define REP_CMP 1
#endif
#ifndef PHASE_COMPRESS
#define PHASE_COMPRESS {}
#endif
#ifndef PHASE_ATTENTION
#define PHASE_ATTENTION {}
#endif

__device__ __forceinline__ void ph_gemm_swiglu(LAS unsigned char* lds, const bf16* A, const bf16* Bt, int N, int K, bf16* O, int ldc, int G, const float* ssq) {
    pg8::Gemm g{A, Bt, M, N, K}; pg8::StaticOrder So; So.init(M, N, G, (int)blockIdx.x);
    pg8::EpiSwiglu E{O, ldc, ssq};
    pg8::gemm_phase<pg8::EpiSwiglu, pg8::StaticOrder, true, true>(lds, g, So, E);
}
template <bool SCALE> __device__ __forceinline__ void ph_gemm_store(LAS unsigned char* lds, const bf16* A, const bf16* Bt, int N, int K, bf16* O, int ldc, int G, const float* ssq) {
    pg8::Gemm g{A, Bt, M, N, K}; pg8::StaticOrder So; So.init(M, N, G, (int)blockIdx.x);
    pg8::EpiStore<SCALE> E{O, ldc, ssq};
    pg8::gemm_phase<pg8::EpiStore<SCALE>, pg8::StaticOrder, true, true>(lds, g, So, E);
}
struct Args { const float* in[15]; float* out; unsigned char* ws; int ph_lo, ph_hi; };
enum { IN_X = 0, IN_RELB, IN_NORMG, IN_FWI, IN_FWO, IN_AWI, IN_AWO, IN_ASINK, IN_BWI, IN_BWO, IN_BPOS, IN_BW1, IN_BW2, IN_CWI, IN_CWO };

__global__ void __launch_bounds__(NWAVES * 64, 2) mega_fwd(Args args) {
    extern __shared__ __attribute__((aligned(16))) unsigned char lds[];
    LAS unsigned char* const L = (LAS unsigned char*)lds;
    volatile LAS unsigned* MISC = (volatile LAS unsigned*)(L + MISC_OFF);
    const int tid = threadIdx.x, lane = tid & 63, wave = __builtin_amdgcn_readfirstlane(tid >> 6);
    const int G = gridDim.x;
    unsigned char* const ws = args.ws;
    gu32* const ctl = (gu32*)(ws + WS_CTL);
    for (int u = tid; u < (LDS_BYTES - LDSCTL_OFF) / 4; u += NWAVES * 64) ((LAS unsigned*)(L + LDSCTL_OFF))[u] = 0u;
    __syncthreads();
    XcdBarrier bar = xcd_barrier_post((unsigned*)(ctl + CW_BAR), MISC + 8);
    const int lo = args.ph_lo, hi = args.ph_hi;
    int pid = 0;
#define PH_BEGIN if (pid >= lo && pid < hi) {
#define PH_END if (pid + 1 < hi) xcd_barrier(bar); } ++pid;
    const int gw = wave * G + (int)blockIdx.x, NGW = G * NWAVES;
    bf16* const HN = (bf16*)(ws + WS_HN); bf16* const Y = (bf16*)(ws + WS_Y); bf16* const OB = (bf16*)(ws + WS_O); bf16* const BIG = (bf16*)(ws + WS_BIG);
    const float* const normg = args.in[IN_NORMG]; float* const SSQ = (float*)(ws + WS_SSQ);

    PH_BEGIN
    for (int rep_ = 0; rep_ < REP_PRO; ++rep_)
    {
#ifndef NO_PRO
        LAS float* scr = (LAS float*)(L + RING_OFF + wave * 16384);
        conv_w<1>(args.in[IN_FWI], 8, D, 2 * DFF, 2 * DFF, (bf16*)(ws + WS_WFI), scr, gw, NGW, lane, normg, 6 * D, 4 * D);
        conv_w<0>(args.in[IN_FWO], 8, DFF, D, D, (bf16*)(ws + WS_WFO), scr, gw, NGW, lane);
        conv_w<0>(args.in[IN_AWI], 2, D, A_IN, A_IN, (bf16*)(ws + WS_WAI), scr, gw, NGW, lane, normg + 2 * D, 0, 18 * D);
        conv_w<0>(args.in[IN_AWO], 2, D, D, D, (bf16*)(ws + WS_WAO), scr, gw, NGW, lane);
        conv_w<0>(args.in[IN_BWI], 1, D, B_IN, B_INP, (bf16*)(ws + WS_WBI), scr, gw, NGW, lane, normg + 8 * D, 0, 0);
        conv_w<0>(args.in[IN_BWO], 1, D, D, D, (bf16*)(ws + WS_WBO), scr, gw, NGW, lane);
        conv_w<0>(args.in[IN_BW1], 2, 2048, 256, 256, (bf16*)(ws + WS_WC1), scr, gw, NGW, lane);
        conv_w<0>(args.in[IN_BW2], 2, 256, 64, 64, (bf16*)(ws + WS_W2T), scr, gw, NGW, lane);
        conv_w<0>(args.in[IN_CWI], 1, D, C_IN, C_IN, (bf16*)(ws + WS_WCI), scr, gw, NGW, lane, normg + 14 * D, 0, 0);
        conv_w<0>(args.in[IN_CWO], 1, D, D, D, (bf16*)(ws + WS_WCO), scr, gw, NGW, lane);
        for (int r = gw; r < B_INP - B_IN; r += NGW) { GAS v4u* p = (GAS v4u*)((bf16*)(ws + WS_WBI) + (size_t)(B_IN + r) * D);
            p[lane] = (v4u){0u, 0u, 0u, 0u}; p[lane + 64] = (v4u){0u, 0u, 0u, 0u}; }
        { float* lutg = (float*)(ws + WS_LUTG); const float* relb = args.in[IN_RELB];
          for (int i = (int)blockIdx.x * 512 + tid; i < 16 * 2048; i += G * 512) { const int h = i >> 11, d = i & 2047; lutg[i] = relb[rel_bucket(d) * 16 + h]; } }
        { float* b1 = (float*)(ws + WS_BIAS1); const float* pos = args.in[IN_BPOS]; const float* w1 = args.in[IN_BW1];
          for (int o = gw; o < 128; o += NGW) { const int kc = o & 15, cb = (o >> 4) & 3, kv = o >> 6; float sacc = 0.f;
#pragma unroll 8
              for (int k = 128 * kc; k < 128 * kc + 128; ++k) sacc += pos[kv * 2048 + k] * w1[((size_t)kv * 2048 + k) * 256 + 64 * cb + lane];
              b1[(kv * 16 + kc) * 256 + 64 * cb + lane] = sacc; } }
        for (int m0 = gw * 4; m0 < M; m0 += NGW * 4) {
#pragma unroll
            for (int r = 0; r < 4; ++r) prep_row(args.in[IN_X] + (size_t)(m0 + r) * D, HN + (size_t)(m0 + r) * D, SSQ + m0 + r, lane); }
#endif
    }
    PH_END

    for (int s = 0; s < 12; ++s) {
        const int Lr = s / 3, j = s % 3, kind = Lr % 3, mj = Lr / 3;
        const float* g6 = normg + (size_t)Lr * 6 * D;
        if (j != 1) {
            const int half = j >> 1;
            PH_BEGIN
#ifndef NO_G1
            for (int rep_ = 0; rep_ < REP_G1; ++rep_)
            ph_gemm_swiglu(L + RING_OFF, HN, (const bf16*)(ws + WS_WFI) + (size_t)(Lr * 2 + half) * 2 * DFF * D, 2 * DFF, D, BIG, DFF, G, SSQ);
#endif
            PH_END
        } else {
            PH_BEGIN
            { const int N = kind == 0 ? A_IN : (kind == 1 ? B_INP : C_IN);
              const bf16* Bt = kind == 0 ? (const bf16*)(ws + WS_WAI) + (size_t)mj * A_IN * D : (kind == 1 ? (const bf16*)(ws + WS_WBI) : (const bf16*)(ws + WS_WCI));
#ifndef NO_G2
              for (int rep_ = 0; rep_ < REP_QKV; ++rep_)
              ph_gemm_store<true>(L + RING_OFF, HN, Bt, N, D, BIG, N, G, SSQ);
#endif
 }
            PH_END
            if (kind == 1) {
                PH_BEGIN
#if defined(FAST_CMP)
                for (int rep_ = 0; rep_ < REP_CMP; ++rep_)
                compress_phase(L + RING_OFF, BIG, (const bf16*)(ws + WS_WC1), (const bf16*)(ws + WS_W2T), (const float*)(ws + WS_BIAS1), (bf16*)(ws + WS_KCB), (bf16*)(ws + WS_VCB), G);
#endif
                PH_END
            }
            PH_BEGIN
            for (int rep_ = 0; rep_ < REP_ATT; ++rep_)
            { const float* lutg = (const float*)(ws + WS_LUTG);
              if (kind == 0) {
#if defined(FAST_A)
                  attn_phase_A(L + RING_OFF, BIG, lutg, args.in[IN_ASINK] + mj * 16, OB, G);
#endif
              } else if (kind == 1) {
#if defined(FAST_B)
                  attn_phase_B(L + RING_OFF, BIG, lutg, (const bf16*)(ws + WS_KCB), (const bf16*)(ws + WS_VCB), OB, G);
#endif
              } else {
#if defined(FAST_C)
                  attn_phase_C(L + RING_OFF, BIG, lutg, OB, G);
#endif
              } }
            PH_END
        }
        PH_BEGIN
        { const int K = (j != 1) ? DFF : D; const bf16* A = (j != 1) ? BIG : OB;
          const bf16* Bt = (j != 1) ? (const bf16*)(ws + WS_WFO) + (size_t)(Lr * 2 + (j >> 1)) * D * DFF
                                    : (kind == 0 ? (const bf16*)(ws + WS_WAO) + (size_t)mj * D * D : (kind == 1 ? (const bf16*)(ws + WS_WBO) : (const bf16*)(ws + WS_WCO)));
#ifndef NO_G3
          for (int rep_ = 0; rep_ < REP_G2; ++rep_)
          ph_gemm_store<false>(L + RING_OFF, A, Bt, D, K, Y, D, G, nullptr);
#endif
 }
        PH_END
        PH_BEGIN
        { const float* gpost = g6 + (size_t)(2 * j + 1) * D;
#ifndef NO_THIN
#if defined(DUP_THIN)
          thin_phase(s == 0 ? args.in[IN_X] : nullptr, HN, OB, (float*)(ws + WS_KMEAN), Y, gpost, j == 1 ? 1.0f : 0.5f, s == 11 ? (float*)(ws + WS_END) : nullptr, gw, NGW, lane);
#endif
          thin_phase(s == 0 ? args.in[IN_X] : nullptr, HN, HN, SSQ, Y, gpost, j == 1 ? 1.0f : 0.5f, s == 11 ? args.out : nullptr, gw, NGW, lane);
#endif
 }
        PH_END
    }
#undef PH_BEGIN
#undef PH_END
}
#ifndef MK_MULTI
#define MK_MULTI 0
#endif
static void launch_range(Args a, int lo, int hi, int grid, hipStream_t stream) {
    a.ph_lo = lo; a.ph_hi = hi;
    hipLaunchKernelGGL(mega_fwd, dim3(grid), dim3(NWAVES * 64), LDS_BYTES, stream, a);
    const hipError_t le = hipPeekAtLastError();
    if (le != hipSuccess) fprintf(stderr, "kernel_launch: launch [%d,%d) failed: %s\n", lo, hi, hipGetErrorName(le));
}
extern "C" void kernel_launch(void* const* d_in, const int* in_sizes, int n_in, void* d_out, int out_size, void* d_ws, size_t ws_size, hipStream_t stream) {
    static int grid = 0;
    if (grid == 0) {
        if (n_in != 15 || in_sizes[0] != M * D || out_size != M * D || ws_size < WS_END) { fprintf(stderr, "kernel_launch: unexpected shapes (n_in %d, in0 %d, out %d, ws %zu)\n", n_in, n_in > 0 ? in_sizes[0] : -1, out_size, ws_size); grid = -1; return; }
        int dev = 0, cus = 0, per_cu = 0;
        if (hipGetDevice(&dev) != hipSuccess || hipDeviceGetAttribute(&cus, hipDeviceAttributeMultiprocessorCount, dev) != hipSuccess) { grid = -1; return; }
        if (hipFuncSetAttribute((const void*)mega_fwd, hipFuncAttributeMaxDynamicSharedMemorySize, LDS_BYTES) != hipSuccess) { fprintf(stderr, "kernel_launch: hipFuncSetAttribute failed\n"); grid = -1; return; }
        if (hipOccupancyMaxActiveBlocksPerMultiprocessor(&per_cu, (const void*)mega_fwd, NWAVES * 64, LDS_BYTES) != hipSuccess || per_cu < 1) { fprintf(stderr, "kernel_launch: occupancy query says %d\n", per_cu); per_cu = 1; }
        (void)hipGetLastError();
        grid = cus;
    }
    if (grid < 0) return;
    if (hipMemsetAsync((char*)d_ws + WS_CTL, 0, CTL_ZERO_BYTES, stream) != hipSuccess) return;
    Args a{};
    for (int i = 0; i < 15; ++i) a.in[i] = (const float*)d_in[i];
    a.out = (float*)d_out; a.ws = (unsigned char*)d_ws;
#if MK_MULTI
    unsigned char* ws = (unsigned char*)d_ws;
    int pid = 0;
    launch_range(a, pid, pid + 1, grid, stream); ++pid;
    for (int s = 0; s < 12; ++s) {
        const int Lr = s / 3, j = s % 3, kind = Lr % 3, mj = Lr / 3; (void)mj;
        if (j != 1) { launch_range(a, pid, pid + 1, grid, stream); ++pid; }
        else {
            launch_range(a, pid, pid + 1, grid, stream); ++pid;
            const bf16* qkv = (const bf16*)(ws + WS_BIG); const float* lutg = (const float*)(ws + WS_LUTG); bf16* ob = (bf16*)(ws + WS_O);
            if (kind == 1) {
#if !defined(FAST_CMP)
                hipLaunchKernelGGL(naive_compress, dim3(NB * 127 * 4 * 2), dim3(256), 0, stream, qkv, a.in[IN_BPOS], a.in[IN_BW1], a.in[IN_BW2], (bf16*)(ws + WS_KCB), (bf16*)(ws + WS_VCB));
#else
                launch_range(a, pid, pid + 1, grid, stream);
#endif
                ++pid;
            }
            bool fast = false;
#if defined(FAST_A)
            if (kind == 0) fast = true;
#endif
#if defined(FAST_B)
            if (kind == 1) fast = true;
#endif
#if defined(FAST_C)
            if (kind == 2) fast = true;
#endif
            if (fast) launch_range(a, pid, pid + 1, grid, stream);
#if defined(NAIVE_ATTN)
            else if (kind == 0) hipLaunchKernelGGL(naive_attn_A, dim3(M * 16), dim3(64), 0, stream, qkv, lutg, a.in[IN_ASINK] + mj * 16, ob);
            else if (kind == 1) hipLaunchKernelGGL(naive_attn_B, dim3(M * 4), dim3(64), 0, stream, qkv, lutg, (const bf16*)(ws + WS_KCB), (const bf16*)(ws + WS_VCB), ob);
            else { hipLaunchKernelGGL(naive_kmean, dim3(NB * 8 * 16), dim3(64), 0, stream, qkv, (float*)(ws + WS_KMEAN));
                   hipLaunchKernelGGL(naive_attn_C, dim3(M * 16), dim3(64), 0, stream, qkv, lutg, (const float*)(ws + WS_KMEAN), ob); }
#endif
            ++pid;
        }
        launch_range(a, pid, pid + 1, grid, stream); ++pid;
        launch_range(a, pid, pid + 1, grid, stream); ++pid;
    }
#else
    launch_range(a, 0, 1000, grid, stream);
#endif
}
```
